# Optimizing an MI355X kernel written in HIP

```python
import jax
import jax.numpy as jnp
from jax import lax
import numpy as np

D_MODEL = 1024
BATCH = 4
SEQ = 8192
DEPTH = 2

N_MIXERS = 4
GROUP_WIDTH = D_MODEL // N_MIXERS
HEAD_DIM = 64
N_HEADS = GROUP_WIDTH // HEAD_DIM
D_FF = ((8 * D_MODEL // 3 + 127) // 128) * 128
CONV_WIDTH = 3
CHUNK = 128
ROPE_BASE = 10000.0
RET_DECAY_EXP0 = 5
RWKV_W_RANK = 32
RWKV_A_RANK = 32
RWKV_G_RANK = 64
RWKV_COLS = 3 * GROUP_WIDTH + 2 * RWKV_W_RANK + 2 * RWKV_A_RANK + RWKV_G_RANK
MLSTM_COLS = 4 * GROUP_WIDTH + 4 * N_HEADS
P_TOTAL = 3 * GROUP_WIDTH + 4 * GROUP_WIDTH + RWKV_COLS + MLSTM_COLS
RMS_EPS = 1e-6
RWKV_GN_EPS = 64e-5

kernel_name = 'hybrid_parallel_mixer_encoder'


def split_cols(t, widths):
    points, acc = [], 0
    for w in widths[:-1]:
        acc += w
        points.append(acc)
    return jnp.split(t, points, axis=-1)


def rms_norm(x, g):
    xf = x.astype(jnp.float32)
    y = xf * lax.rsqrt(jnp.mean(xf * xf, axis=-1, keepdims=True) + RMS_EPS)
    return (y * g.astype(jnp.float32)).astype(x.dtype)


def swiglu(h, w_gate, w_up, w_down):
    return (jax.nn.silu(h @ w_gate) * (h @ w_up)) @ w_down


def heads(t):
    b, s, _ = t.shape
    return t.reshape(b, s, N_HEADS, HEAD_DIM).transpose(0, 2, 1, 3)


def merge_heads(t):
    b, h, s, d = t.shape
    return t.transpose(0, 2, 1, 3).reshape(b, s, h * d)


def to_chunks(t):
    b, h, s = t.shape[:3]
    t = t.reshape(b, h, s // CHUNK, CHUNK, *t.shape[3:])
    return jnp.moveaxis(t, 2, 0)


def from_chunks(t):
    t = jnp.moveaxis(t, 0, 2)
    b, h, nc, l = t.shape[:4]
    return t.reshape(b, h, nc * l, *t.shape[4:])


def rope_tables(seq):
    inv = ROPE_BASE ** (-jnp.arange(0, HEAD_DIM, 2, dtype=jnp.float32) / HEAD_DIM)
    ang = jnp.arange(seq, dtype=jnp.float32)[:, None] * inv[None, :]
    return jnp.cos(ang), jnp.sin(ang)


def rotary(t, cos, sin):
    t1, t2 = jnp.split(t, 2, axis=-1)
    return jnp.concatenate([t1 * cos - t2 * sin, t1 * sin + t2 * cos], axis=-1)


def short_conv_mixer(zb, zc, zh, conv_w, conv_b):
    u = zc * zh
    y = lax.conv_general_dilated(
        u, conv_w[:, None, :].astype(u.dtype), window_strides=(1,),
        padding=[(CONV_WIDTH // 2, CONV_WIDTH // 2)],
        dimension_numbers=('NWC', 'WIO', 'NWC'), feature_group_count=GROUP_WIDTH)
    return zb * (y + conv_b.astype(y.dtype))


def retention_scan(q, k, v, log_gamma, include_diag):
    idx = jnp.arange(CHUNK, dtype=jnp.float32)
    rel = idx[:, None] - idx[None, :]
    mask = (rel >= 0) if include_diag else (rel > 0)
    intra = jnp.where(mask, jnp.exp(jnp.where(mask, rel, 0.0) * log_gamma[:, None, None]), 0.0)
    q_dec = jnp.exp((idx + 1.0) * log_gamma[:, None])
    k_dec = jnp.exp((CHUNK - 1.0 - idx) * log_gamma[:, None])
    c_dec = jnp.exp(CHUNK * log_gamma)

    def step(state, inp):
        qc, kc, vc = inp
        s = jnp.einsum('bhtd,bhsd->bhts', qc, kc) * intra
        out = (jnp.einsum('bhts,bhsv->bhtv', s, vc)
               + q_dec[:, :, None] * jnp.einsum('bhtk,bhkv->bhtv', qc, state))
        state = c_dec[:, None, None] * state + jnp.einsum('bhsk,bhsv->bhkv', kc * k_dec[:, :, None], vc)
        return state, out

    b, h, _, d = q.shape
    state0 = jnp.zeros((b, h, d, d), jnp.float32)
    _, out = lax.scan(step, state0, (to_chunks(q), to_chunks(k), to_chunks(v)))
    return from_chunks(out)


def retention_mixer(zq, zk, zv, zg, decay_logit, cos, sin):
    f32 = jnp.float32
    q = rotary(heads(zq.astype(f32)), cos, sin) * HEAD_DIM ** -0.5
    k = rotary(heads(zk.astype(f32)), cos, sin)
    v = heads(zv.astype(f32))
    log_gamma = jax.nn.log_sigmoid(decay_logit.astype(f32))
    fwd = retention_scan(q, k, v, log_gamma[0], True)
    bwd = jnp.flip(retention_scan(jnp.flip(q, 2), jnp.flip(k, 2), jnp.flip(v, 2), log_gamma[1], False), 2)
    o = fwd + bwd
    o = o * lax.rsqrt(jnp.mean(o * o, axis=-1, keepdims=True) + RMS_EPS)
    return (jax.nn.silu(zg.astype(f32)) * merge_heads(o)).astype(zq.dtype)


def rwkv7_scan(r, w, k, v, kk, a, reverse):
    def step(state, inp):
        rt, wt, kt, vt, kkt, at = inp
        sa = jnp.einsum('bhvk,bhk->bhv', state, -kkt)
        state = (state * wt[:, :, None, :] + sa[..., None] * (kkt * at)[:, :, None, :]
                 + vt[..., None] * kt[:, :, None, :])
        return state, jnp.einsum('bhvk,bhk->bhv', state, rt)

    b, _, h, n = r.shape
    state0 = jnp.zeros((b, h, n, n), jnp.float32)
    xs = (jnp.moveaxis(r, 1, 0), jnp.moveaxis(w, 1, 0), jnp.moveaxis(k, 1, 0),
          jnp.moveaxis(v, 1, 0), jnp.moveaxis(kk, 1, 0), jnp.moveaxis(a, 1, 0))
    _, out = lax.scan(step, state0, xs, reverse=reverse)
    return jnp.moveaxis(out, 0, 1)


def rwkv7_mixer(zw, mu, w0, w2, a0, a2, g2, k_k, k_a, r_k, ln_w, ln_b):
    f32 = jnp.float32
    G = GROUP_WIDTH
    b, s, _ = zw.shape
    z = zw.astype(f32)
    zp = jnp.pad(z, ((0, 0), (1, 1), (0, 0)))
    z = z + mu * (0.5 * (zp[:, :-2] + zp[:, 2:]) - z)
    r, k, v, wl, al, gl = split_cols(z, [G, G, G, 2 * RWKV_W_RANK, 2 * RWKV_A_RANK, RWKV_G_RANK])
    wl = wl.reshape(b, s, 2, RWKV_W_RANK)
    al = al.reshape(b, s, 2, RWKV_A_RANK)
    w_log = -jax.nn.softplus(-(w0 + jnp.einsum('bsdr,drc->bsdc', jnp.tanh(wl), w2))) - 0.5
    decay = jnp.exp(-jnp.exp(w_log))
    a = jax.nn.sigmoid(a0 + jnp.einsum('bsdr,drc->bsdc', al, a2))
    gate = jax.nn.sigmoid(gl) @ g2
    hs = lambda t: t.reshape(b, s, N_HEADS, HEAD_DIM)
    kk = hs(k * k_k)
    kk = kk / jnp.maximum(jnp.sqrt(jnp.sum(kk * kk, axis=-1, keepdims=True)), 1e-12)
    rh, vh = hs(r), hs(v)
    wkv = jnp.zeros_like(rh)
    bonus = jnp.zeros_like(rh)
    for d, rev in ((0, False), (1, True)):
        kd = hs(k * (1.0 + (a[:, :, d] - 1.0) * k_a))
        wkv = wkv + rwkv7_scan(rh, hs(decay[:, :, d]), kd, vh, kk, hs(a[:, :, d]), rev)
        bonus = bonus + jnp.sum(rh * kd * r_k, axis=-1, keepdims=True) * vh
    mean = jnp.mean(wkv, axis=-1, keepdims=True)
    var = jnp.mean((wkv - mean) ** 2, axis=-1, keepdims=True)
    wkv = (wkv - mean) * lax.rsqrt(var + RWKV_GN_EPS)
    out = wkv.reshape(b, s, G) * ln_w + ln_b + bonus.reshape(b, s, G)
    return (out * gate).astype(zw.dtype)


def mlstm_chunkwise(q, k, v, log_i, log_f):
    b, h, _, d = q.shape
    tril = jnp.tril(jnp.ones((CHUNK, CHUNK), dtype=bool))

    def step(carry, inp):
        c_mat, n_vec, m_prev = carry
        qc, kc, vc, li, lf = inp
        bcum = jnp.cumsum(lf, axis=-1)
        d_log = jnp.where(tril, bcum[..., :, None] - bcum[..., None, :] + li[..., None, :], -jnp.inf)
        inter_log = bcum + m_prev[..., None]
        m_t = jnp.maximum(inter_log, jnp.max(d_log, axis=-1))
        inter_w = jnp.exp(inter_log - m_t)
        s = jnp.einsum('bhtd,bhsd->bhts', qc, kc) * jnp.exp(d_log - m_t[..., None])
        num = (jnp.einsum('bhts,bhsv->bhtv', s, vc)
               + inter_w[..., None] * jnp.einsum('bhvk,bhtk->bhtv', c_mat, qc))
        den = jnp.sum(s, axis=-1) + inter_w * jnp.einsum('bhk,bhtk->bht', n_vec, qc)
        out = num / jnp.maximum(jnp.abs(den), jnp.exp(-m_t))[..., None]
        b_end = bcum[..., -1]
        w_log = b_end[..., None] - bcum + li
        m_new = jnp.maximum(b_end + m_prev, jnp.max(w_log, axis=-1))
        old_w = jnp.exp(b_end + m_prev - m_new)
        new_w = jnp.exp(w_log - m_new[..., None])
        c_mat = old_w[..., None, None] * c_mat + jnp.einsum('bhs,bhsv,bhsk->bhvk', new_w, vc, kc)
        n_vec = old_w[..., None] * n_vec + jnp.einsum('bhs,bhsk->bhk', new_w, kc)
        return (c_mat, n_vec, m_new), out

    carry0 = (jnp.zeros((b, h, d, d), jnp.float32), jnp.zeros((b, h, d), jnp.float32),
              jnp.zeros((b, h), jnp.float32))
    _, out = lax.scan(step, carry0, (to_chunks(q), to_chunks(k), to_chunks(v),
                                     to_chunks(log_i), to_chunks(log_f)))
    return from_chunks(out)


def mlstm_mixer(zq, zk, zv, zo, zi, zf, i_bias, f_bias, norm_w):
    f32 = jnp.float32
    b, s, _ = zq.shape
    q = heads(zq.astype(f32)) * HEAD_DIM ** -0.5
    k = heads(zk.astype(f32))
    v = heads(zv.astype(f32))
    gi = zi.astype(f32).reshape(b, s, 2, N_HEADS) + i_bias
    gf = zf.astype(f32).reshape(b, s, 2, N_HEADS) + f_bias
    log_i = jnp.transpose(gi, (2, 0, 3, 1))
    log_f = jnp.transpose(jax.nn.log_sigmoid(gf), (2, 0, 3, 1))
    fwd = mlstm_chunkwise(q, k, v, log_i[0], log_f[0])
    bwd = jnp.flip(mlstm_chunkwise(jnp.flip(q, 2), jnp.flip(k, 2), jnp.flip(v, 2),
                                   jnp.flip(log_i[1], -1), jnp.flip(log_f[1], -1)), 2)
    hsum = fwd + bwd
    hsum = hsum * lax.rsqrt(jnp.mean(hsum * hsum, axis=-1, keepdims=True) + RMS_EPS)
    return (jax.nn.sigmoid(zo.astype(f32)) * merge_heads(hsum) * norm_w).astype(zq.dtype)


def setup_inputs(seed: int = 0) -> dict:
    key = jax.random.key(seed)
    ks = jax.random.split(key, 32)
    f32 = jnp.float32
    G = GROUP_WIDTH
    nrm = lambda k, shape, fan_in: jax.random.normal(k, shape, f32) * fan_in ** -0.5
    noise = lambda k, shape, sc: sc * jax.random.normal(k, shape, f32)
    p = jnp.arange(RET_DECAY_EXP0, RET_DECAY_EXP0 + N_HEADS, dtype=f32)
    return {
        'x': jax.random.normal(ks[0], (BATCH, SEQ, D_MODEL), f32),
        'norm_g': 1.0 + noise(ks[1], (DEPTH, 6, D_MODEL), 0.02),
        'ffn_w_gate': nrm(ks[2], (DEPTH, 2, D_MODEL, D_FF), D_MODEL),
        'ffn_w_up': nrm(ks[3], (DEPTH, 2, D_MODEL, D_FF), D_MODEL),
        'ffn_w_down': nrm(ks[4], (DEPTH, 2, D_FF, D_MODEL), D_FF),
        'w_in': nrm(ks[5], (DEPTH, D_MODEL, P_TOTAL), D_MODEL),
        'w_out': nrm(ks[6], (DEPTH, D_MODEL, D_MODEL), D_MODEL),
        'conv_w': nrm(ks[7], (DEPTH, CONV_WIDTH, G), CONV_WIDTH),
        'conv_b': noise(ks[8], (DEPTH, G), 0.02),
        'ret_decay_logit': jnp.log(2.0 ** p - 1.0) + noise(ks[9], (DEPTH, 2, N_HEADS), 0.05),
        'rwkv_mu': jax.random.uniform(ks[10], (DEPTH, RWKV_COLS), f32),
        'rwkv_w0': jax.random.uniform(ks[11], (DEPTH, 2, G), f32, minval=-6.0, maxval=-1.0),
        'rwkv_w2': nrm(ks[12], (DEPTH, 2, RWKV_W_RANK, G), RWKV_W_RANK),
        'rwkv_a0': noise(ks[13], (DEPTH, 2, G), 0.1),
        'rwkv_a2': nrm(ks[14], (DEPTH, 2, RWKV_A_RANK, G), RWKV_A_RANK),
        'rwkv_g2': nrm(ks[15], (DEPTH, RWKV_G_RANK, G), RWKV_G_RANK),
        'rwkv_k_k': 0.85 + noise(ks[16], (DEPTH, G), 0.02),
        'rwkv_k_a': 1.0 + noise(ks[17], (DEPTH, G), 0.02),
        'rwkv_r_k': noise(ks[18], (DEPTH, N_HEADS, HEAD_DIM), 0.1),
        'rwkv_ln_w': 1.0 + noise(ks[19], (DEPTH, G), 0.02),
        'rwkv_ln_b': noise(ks[20], (DEPTH, G), 0.02),
        'mlstm_i_bias': noise(ks[21], (DEPTH, 2, N_HEADS), 0.1),
        'mlstm_f_bias': jax.random.uniform(ks[22], (DEPTH, 2, N_HEADS), f32, minval=3.0, maxval=6.0),
        'mlstm_norm_w': 1.0 + noise(ks[23], (DEPTH, G), 0.02),
    }


def reference(x, norm_g, ffn_w_gate, ffn_w_up, ffn_w_down, w_in, w_out, conv_w, conv_b,
              ret_decay_logit, rwkv_mu, rwkv_w0, rwkv_w2, rwkv_a0, rwkv_a2, rwkv_g2,
              rwkv_k_k, rwkv_k_a, rwkv_r_k, rwkv_ln_w, rwkv_ln_b,
              mlstm_i_bias, mlstm_f_bias, mlstm_norm_w):
    G = GROUP_WIDTH
    cos, sin = rope_tables(x.shape[1])
    widths = [G, G, G,
              G, G, G, G,
              RWKV_COLS,
              G, G, G, G, 2 * N_HEADS, 2 * N_HEADS]
    for l in range(DEPTH):
        g = norm_g[l]
        h = rms_norm(x, g[0])
        x = x + 0.5 * rms_norm(swiglu(h, ffn_w_gate[l, 0], ffn_w_up[l, 0], ffn_w_down[l, 0]), g[1])
        h = rms_norm(x, g[2])
        z = h @ w_in[l]
        cb, cc, ch, rq, rk, rv, rg, zw, mq, mk, mv, mo, mi, mf = split_cols(z, widths)
        y_conv = short_conv_mixer(cb, cc, ch, conv_w[l], conv_b[l])
        y_ret = retention_mixer(rq, rk, rv, rg, ret_decay_logit[l], cos, sin)
        y_rwkv = rwkv7_mixer(zw, rwkv_mu[l], rwkv_w0[l], rwkv_w2[l], rwkv_a0[l], rwkv_a2[l],
                             rwkv_g2[l], rwkv_k_k[l], rwkv_k_a[l], rwkv_r_k[l],
                             rwkv_ln_w[l], rwkv_ln_b[l])
        y_mlstm = mlstm_mixer(mq, mk, mv, mo, mi, mf, mlstm_i_bias[l], mlstm_f_bias[l], mlstm_norm_w[l])
        y = jnp.concatenate([y_conv.astype(z.dtype), y_ret.astype(z.dtype),
                             y_rwkv.astype(z.dtype), y_mlstm.astype(z.dtype)], axis=-1) @ w_out[l]
        x = x + rms_norm(y, g[3])
        h = rms_norm(x, g[4])
        x = x + 0.5 * rms_norm(swiglu(h, ffn_w_gate[l, 1], ffn_w_up[l, 1], ffn_w_down[l, 1]), g[5])
    return x
```

```cpp
#include <hip/hip_runtime.h>
#include <hip/hip_cooperative_groups.h>
#include <cstdio>
#include <cstdint>
namespace cg = cooperative_groups;
namespace pg8 {
#define PG8_LAS __attribute__((address_space(3)))
typedef unsigned short bf16_t;
typedef short bf16x8 __attribute__((ext_vector_type(8)));
typedef float f32x4 __attribute__((ext_vector_type(4)));
typedef unsigned u32x4 __attribute__((ext_vector_type(4)));
constexpr int BM = 256, BK = 64, HALF = 128, HTB = HALF * BK * 2, STAGE_BYTES = 8 * HTB, NXCD = 8, WGM = 8;
__host__ __device__ __forceinline__ int lds_byte(int r, int c) { const int st = (r >> 4) * 2 + (c >> 5), rr = r & 15, cc = c & 31, ob = rr * 64 + cc * 2; return st * 1024 + (ob ^ (((ob >> 9) & 1) << 5)); }
__host__ __device__ __forceinline__ void stage_rc(int b, int& R, int& C) { const int st = b / 1024, sb = b % 1024, swz = sb ^ (((sb >> 9) & 1) << 5); R = (st >> 1) * 16 + swz / 64; C = (st & 1) * 32 + (swz % 64) / 2; }
__host__ __device__ __forceinline__ int perm32(int rho) { const int n = rho >> 4, i = rho & 15; return 8 * (i >> 2) + 4 * n + (i & 3); }
struct Unit { int pm, pn; };
struct Gemm { const bf16_t* A; const bf16_t* Bt; int M, N, K; };
struct StaticOrder {
    int nM, nN, nwg, G, c;
    __host__ __device__ void init(int M, int N, int G_, int c_) { nM = M / BM; nN = N / BM; nwg = nM * nN; G = G_; c = c_; }
    __host__ __device__ bool next(int i, Unit& u) const {
        const long L = (long)i * G + c; if (L >= nwg) return false;
        int wgid = (int)L; { const int q = nwg / NXCD, r = nwg % NXCD, xcd = wgid % NXCD, off = wgid / NXCD; wgid = (xcd < r ? xcd * (q + 1) : r * (q + 1) + (xcd - r) * q) + off; }
        const int nig = WGM * nN, gid = wgid / nig, fm = gid * WGM, gsz = (nM - fm) < WGM ? (nM - fm) : WGM;
        u.pm = fm + ((wgid % nig) % gsz); u.pn = (wgid % nig) / gsz; return true;
    }
    __device__ __forceinline__ void a_ready(const Unit&) const {}
    __device__ __forceinline__ void done(const Unit&) const {}
};
__device__ __forceinline__ unsigned cvt_pk_bf16(float lo, float hi) { unsigned r; asm volatile("v_cvt_pk_bf16_f32 %0, %1, %2" : "=v"(r) : "v"(lo), "v"(hi)); return r; }
struct EpiBf16 {
    static constexpr bool PERM = true, AFTER_DRAIN = false;
    bf16_t* O; int ldc;
    __device__ __forceinline__ void operator()(const f32x4 (&acc)[2][2][4][2], const Unit& u, int wr, int wc, int fr, int fq) const {
        const int row0 = u.pm * BM + wr * 64 + fr; const int col0 = u.pn * BM + wc * 32 + 8 * fq;
#pragma unroll
        for (int ai = 0; ai < 2; ++ai)
#pragma unroll
            for (int m = 0; m < 4; ++m) { bf16_t* rowp = O + (size_t)(row0 + ai * HALF + m * 16) * ldc + col0;
#pragma unroll
                for (int bj = 0; bj < 2; ++bj) { const f32x4 v0 = acc[ai][bj][m][0], v1 = acc[ai][bj][m][1];
                    u32x4 w; w.x = cvt_pk_bf16(v0[0], v0[1]); w.y = cvt_pk_bf16(v0[2], v0[3]); w.z = cvt_pk_bf16(v1[0], v1[1]); w.w = cvt_pk_bf16(v1[2], v1[3]);
                    *(u32x4*)(rowp + bj * HALF) = w; } }
    }
};
__device__ __forceinline__ float silu_f(float g) { return g * __builtin_amdgcn_rcpf(1.0f + __expf(-g)); }
struct EpiSwiGLU {
    static constexpr bool PERM = true, AFTER_DRAIN = false;
    bf16_t* O; int ldc;
    __device__ __forceinline__ void operator()(const f32x4 (&acc)[2][2][4][2], const Unit& u, int wr, int wc, int fr, int fq) const {
        const int row0 = u.pm * BM + wr * 64 + fr; const int col0 = u.pn * HALF + wc * 32 + 8 * fq;
#pragma unroll
        for (int ai = 0; ai < 2; ++ai)
#pragma unroll
            for (int m = 0; m < 4; ++m) { bf16_t* rowp = O + (size_t)(row0 + ai * HALF + m * 16) * ldc + col0;
                const f32x4 g0 = acc[ai][0][m][0], g1 = acc[ai][0][m][1], u0 = acc[ai][1][m][0], u1 = acc[ai][1][m][1];
                u32x4 w;
                w.x = cvt_pk_bf16(silu_f(g0[0]) * u0[0], silu_f(g0[1]) * u0[1]); w.y = cvt_pk_bf16(silu_f(g0[2]) * u0[2], silu_f(g0[3]) * u0[3]);
                w.z = cvt_pk_bf16(silu_f(g1[0]) * u1[0], silu_f(g1[1]) * u1[1]); w.w = cvt_pk_bf16(silu_f(g1[2]) * u1[2], silu_f(g1[3]) * u1[3]);
                *(u32x4*)rowp = w; }
    }
};
template <class Epi, class Sched, bool ALIGN_EPI = false, bool SP2 = false>
__device__ __forceinline__ void gemm_phase(PG8_LAS unsigned char* lds, const Gemm g, const Sched& S, const Epi& E) {
    int tid = threadIdx.x; asm volatile("" : "+v"(tid)); const int wid = __builtin_amdgcn_readfirstlane(tid >> 6), lane = tid & 63, wr = wid >> 2, wc = wid & 3, fr = lane & 15, fq = lane >> 4;
    const int K = g.K, nt = K / BK;
    unsigned voffA[2], voffB[2];
#pragma unroll
    for (int i = 0; i < 2; ++i) { int R, C; stage_rc(tid * 16 + i * 8192, R, C); const int Rb = Epi::PERM ? ((R & ~31) + perm32(R & 31)) : R;
        voffA[i] = (unsigned)(R * K + C) * 2u; voffB[i] = (unsigned)(Rb * K + C) * 2u; }
    const size_t kstep = (size_t)(BK * 2);
    const size_t hstep = (size_t)HALF * K * 2;
    const size_t tstep = 2 * hstep;
    const unsigned ldsw = (unsigned)wid * 1024u;
    const int aoff = lds_byte(wr * 64 + fr, fq * 8), boff = lds_byte(wc * 32 + fr, fq * 8);
#define PG8_SA(b, h) (((b) * 2 + (h)) * HTB)
#define PG8_SB(b, h) ((4 + (b) * 2 + (h)) * HTB)
#define PG8_STAGE(bufoff, gbase, voff) do { _Pragma("unroll") for (int _i = 0; _i < 2; ++_i) \
        __builtin_amdgcn_global_load_lds((const unsigned*)((const char*)(gbase) + (voff)[_i]), (PG8_LAS unsigned*)(lds + (bufoff) + ldsw + _i * 8192), 16, 0, 0); } while (0)
#define PG8_LDA(dst, b, h) do { _Pragma("unroll") for (int m = 0; m < 4; ++m) _Pragma("unroll") for (int k = 0; k < 2; ++k) dst[m][k] = *(const PG8_LAS bf16x8*)(lds + PG8_SA(b, h) + aoff + m * 2048 + k * 1024); } while (0)
#define PG8_LDB(dst, b, h) do { _Pragma("unroll") for (int n = 0; n < 2; ++n) _Pragma("unroll") for (int k = 0; k < 2; ++k) dst[n][k] = *(const PG8_LAS bf16x8*)(lds + PG8_SB(b, h) + boff + n * 2048 + k * 1024); } while (0)
#define PG8_MMA(ai, bj, At, Bt) do { __builtin_amdgcn_s_setprio(1); _Pragma("unroll") for (int m = 0; m < 4; ++m) _Pragma("unroll") for (int n = 0; n < 2; ++n) _Pragma("unroll") for (int k = 0; k < 2; ++k) \
        acc[ai][bj][m][n] = __builtin_amdgcn_mfma_f32_16x16x32_bf16(Bt[n][k], At[m][k], acc[ai][bj][m][n], 0, 0, 0); __builtin_amdgcn_s_setprio(0); } while (0)
#define PG8_WAIT_V(n) asm volatile("s_waitcnt vmcnt(" #n ")" ::: "memory")
#define PG8_WAIT_L(n) asm volatile("s_waitcnt lgkmcnt(" #n ")" ::: "memory")
#define PG8_BAR __builtin_amdgcn_s_barrier()
#define PG8_SCHED __builtin_amdgcn_sched_barrier(0)
    Unit cur, nxt; int ui = 0;
    if (!S.next(0, cur)) return;
    f32x4 acc[2][2][4][2];
#pragma unroll
    for (int a = 0; a < 2; ++a)
#pragma unroll
        for (int b = 0; b < 2; ++b)
#pragma unroll
            for (int m = 0; m < 4; ++m)
#pragma unroll
                for (int n = 0; n < 2; ++n) acc[a][b][m][n] = (f32x4){0.f, 0.f, 0.f, 0.f};
    bf16x8 At[4][2], B0[2][2], B1[2][2];
    const char* cA = (const char*)g.A + (size_t)cur.pm * tstep; const char* cB = (const char*)g.Bt + (size_t)cur.pn * tstep;
    S.a_ready(cur);
    if constexpr (SP2) {
        PG8_STAGE(PG8_SB(0, 0), cB, voffB); PG8_STAGE(PG8_SB(0, 1), cB + hstep, voffB); PG8_STAGE(PG8_SA(0, 0), cA, voffA); PG8_STAGE(PG8_SA(0, 1), cA + hstep, voffA);
        if (wr == 1) PG8_BAR;
        PG8_WAIT_V(2); PG8_BAR;
        PG8_STAGE(PG8_SB(1, 0), cB + kstep, voffB); PG8_STAGE(PG8_SA(1, 0), cA + kstep, voffA); PG8_STAGE(PG8_SB(1, 1), cB + hstep + kstep, voffB);
        PG8_WAIT_V(6); PG8_BAR;
    } else {
        PG8_STAGE(PG8_SB(0, 0), cB, voffB); PG8_STAGE(PG8_SA(0, 0), cA, voffA); PG8_STAGE(PG8_SB(0, 1), cB + hstep, voffB); PG8_STAGE(PG8_SA(0, 1), cA + hstep, voffA);
        if (wr == 1) PG8_BAR;
        PG8_WAIT_V(4); PG8_BAR;
        PG8_STAGE(PG8_SB(1, 0), cB + kstep, voffB); PG8_STAGE(PG8_SA(1, 0), cA + kstep, voffA); PG8_STAGE(PG8_SB(1, 1), cB + hstep + kstep, voffB);
        PG8_WAIT_V(6); PG8_BAR;
    }
    for (;;) {
        const bool has_next = S.next(ui + 1, nxt);
        const char* nA = has_next ? (const char*)g.A + (size_t)nxt.pm * tstep : cA; const char* nB = has_next ? (const char*)g.Bt + (size_t)nxt.pn * tstep : cB;
        for (int t = 0; t < nt; t += 2) {
            const bool last = (t == nt - 2);
            const char* a1 = cA + (size_t)(t + 1) * kstep;
            const char* a2 = last ? nA : cA + (size_t)(t + 2) * kstep; const char* b2 = last ? nB : cB + (size_t)(t + 2) * kstep;
            const char* a3 = a2 + kstep; const char* b3 = b2 + kstep;
            if (last && has_next) S.a_ready(nxt);
            if constexpr (SP2) {
            PG8_LDB(B0, 0, 0); PG8_LDB(B1, 0, 1); PG8_SCHED; PG8_LDA(At, 0, 0); PG8_STAGE(PG8_SA(1, 1), a1 + hstep, voffA);
            PG8_WAIT_V(8); PG8_WAIT_L(0); PG8_BAR; PG8_MMA(0, 0, At, B0); PG8_MMA(0, 1, At, B1); PG8_BAR; PG8_SCHED;
            PG8_LDA(At, 0, 1); PG8_STAGE(PG8_SB(0, 0), b2, voffB); PG8_STAGE(PG8_SB(0, 1), b2 + hstep, voffB); PG8_STAGE(PG8_SA(0, 0), a2, voffA);
            PG8_WAIT_V(8); PG8_WAIT_L(0); PG8_BAR; PG8_MMA(1, 0, At, B0); PG8_MMA(1, 1, At, B1); PG8_BAR; PG8_SCHED;
            PG8_LDB(B0, 1, 0); PG8_LDB(B1, 1, 1); PG8_SCHED; PG8_LDA(At, 1, 0); PG8_STAGE(PG8_SA(0, 1), a2 + hstep, voffA);
            PG8_WAIT_V(8); PG8_WAIT_L(0); PG8_BAR; PG8_MMA(0, 0, At, B0); PG8_MMA(0, 1, At, B1); PG8_BAR; PG8_SCHED;
            PG8_LDA(At, 1, 1); PG8_STAGE(PG8_SB(1, 0), b3, voffB); PG8_STAGE(PG8_SB(1, 1), b3 + hstep, voffB); PG8_STAGE(PG8_SA(1, 0), a3, voffA);
            PG8_WAIT_V(8); PG8_WAIT_L(0); PG8_BAR; PG8_MMA(1, 0, At, B0); PG8_MMA(1, 1, At, B1); PG8_BAR; PG8_SCHED;
            } else {
            PG8_LDB(B0, 0, 0); PG8_SCHED; PG8_LDA(At, 0, 0); PG8_STAGE(PG8_SA(1, 1), a1 + hstep, voffA);
            PG8_WAIT_L(8); PG8_BAR; PG8_WAIT_L(0); PG8_MMA(0, 0, At, B0); PG8_BAR; PG8_SCHED;
            PG8_LDB(B1, 0, 1); PG8_STAGE(PG8_SB(0, 0), b2, voffB);
            PG8_BAR; PG8_WAIT_L(0); PG8_MMA(0, 1, At, B1); PG8_BAR;
            PG8_LDA(At, 0, 1); PG8_STAGE(PG8_SA(0, 0), a2, voffA);
            PG8_BAR; PG8_WAIT_L(0); PG8_MMA(1, 0, At, B0); PG8_BAR; PG8_SCHED;
            PG8_STAGE(PG8_SB(0, 1), b2 + hstep, voffB);
            PG8_WAIT_V(6); PG8_BAR; PG8_MMA(1, 1, At, B1); PG8_BAR;
            PG8_LDB(B0, 1, 0); PG8_SCHED; PG8_LDA(At, 1, 0); PG8_STAGE(PG8_SA(0, 1), a2 + hstep, voffA);
            PG8_WAIT_L(8); PG8_BAR; PG8_WAIT_L(0); PG8_MMA(0, 0, At, B0); PG8_BAR; PG8_SCHED;
            PG8_LDB(B1, 1, 1); PG8_STAGE(PG8_SB(1, 0), b3, voffB);
            PG8_BAR; PG8_WAIT_L(0); PG8_MMA(0, 1, At, B1); PG8_BAR;
            PG8_LDA(At, 1, 1); PG8_STAGE(PG8_SA(1, 0), a3, voffA);
            PG8_BAR; PG8_WAIT_L(0); PG8_MMA(1, 0, At, B0); PG8_BAR; PG8_SCHED;
            PG8_STAGE(PG8_SB(1, 1), b3 + hstep, voffB);
            PG8_WAIT_V(6); PG8_BAR; PG8_MMA(1, 1, At, B1); PG8_BAR;
            }
        }
        if constexpr (ALIGN_EPI) { if (wr == 0) PG8_BAR; }
        if constexpr (!Epi::AFTER_DRAIN) { E(acc, cur, wr, wc, fr, fq); S.done(cur); }
        if (!has_next) break;
#pragma unroll
        for (int a = 0; a < 2; ++a)
#pragma unroll
            for (int b = 0; b < 2; ++b)
#pragma unroll
                for (int m = 0; m < 4; ++m)
#pragma unroll
                    for (int n = 0; n < 2; ++n) acc[a][b][m][n] = (f32x4){0.f, 0.f, 0.f, 0.f};
        cur = nxt; cA = nA; cB = nB; ++ui;
        if constexpr (ALIGN_EPI) { if (wr == 1) PG8_BAR; }
    }
    PG8_WAIT_V(0);
    if constexpr (!ALIGN_EPI) { if (wr == 0) PG8_BAR; }
    PG8_BAR;
    if constexpr (Epi::AFTER_DRAIN) { E.fused(acc, cur, wr, wc, fr, fq, lds, wid, lane); S.done(cur); }
#undef PG8_SA
#undef PG8_SB
#undef PG8_STAGE
#undef PG8_LDA
#undef PG8_LDB
#undef PG8_MMA
#undef PG8_WAIT_V
#undef PG8_WAIT_L
#undef PG8_BAR
#undef PG8_SCHED
}
}

#define DEV __device__ __forceinline__
typedef unsigned short bf16_t;
typedef float f32x4 __attribute__((ext_vector_type(4)));
typedef float f32x2 __attribute__((ext_vector_type(2)));
typedef unsigned u32x4 __attribute__((ext_vector_type(4)));
typedef unsigned u32x2 __attribute__((ext_vector_type(2)));
constexpr int MR = 32768, SEQ = 8192, DM = 1024, DFF = 2816, PT = 3792, ZLD = 3840, NB = 4, NH = 4;
constexpr float RMS_EPS = 1e-6f;
constexpr size_t MiB = 1u << 20;
constexpr size_t WS_WGU = 1 * MiB, WS_WD = 23 * MiB, WS_WIN = 34 * MiB, WS_WOUT = 42 * MiB, WS_ROPE = 44 * MiB;
constexpr size_t WS_XB = 46 * MiB, WS_BIG = 110 * MiB, WS_SCR = 350 * MiB;
constexpr size_t WS_D = WS_SCR;
constexpr size_t WS_RET = WS_SCR, WS_MLC = WS_SCR + 32 * MiB, WS_MLN = WS_SCR + 64 * MiB, WS_MLS = WS_SCR + 64 * MiB + 512 * 1024;
constexpr size_t WS_PE = WS_SCR + 65 * MiB, WS_WKV = WS_SCR + 97 * MiB, WS_SBON = WS_SCR + 161 * MiB, WS_END = 512 * MiB;
constexpr int LDS_BYTES = 163840;
constexpr int RW_LC = 256, RW_NC = SEQ / RW_LC, RW_T = 8;
constexpr int CH = 128, NCH = SEQ / CH;

struct Params { const float* in[24]; float* out; unsigned char* ws; };
typedef const __attribute__((address_space(4))) Params* PP;
DEV PP fresh_params() { PP q = (PP)__builtin_amdgcn_kernarg_segment_ptr(); asm volatile("" : "+s"(q)); return q; }
DEV int otid() { int t = threadIdx.x; asm volatile("" : "+v"(t)); return t; }

DEV float bf2f(bf16_t v) { return __uint_as_float(((unsigned)v) << 16); }
DEV unsigned f2bf(float f) { unsigned u = __float_as_uint(f); return (u + 0x7fffu + ((u >> 16) & 1u)) >> 16; }
DEV unsigned pk2(float lo, float hi) { return f2bf(lo) | (f2bf(hi) << 16); }
DEV float wave_sum(float v) {
#pragma unroll
    for (int o = 1; o < 64; o <<= 1) v += __shfl_xor(v, o);
    return v;
}
DEV float sigmoid_f(float x) { return 1.0f / (1.0f + __expf(-x)); }
DEV float softplus_f(float x) { return fmaxf(x, 0.f) + log1pf(__expf(-fabsf(x))); }
DEV void unpack8(const u32x4 w, float* f) {
    f[0] = __uint_as_float(w.x << 16); f[1] = __uint_as_float(w.x & 0xffff0000u); f[2] = __uint_as_float(w.y << 16); f[3] = __uint_as_float(w.y & 0xffff0000u);
    f[4] = __uint_as_float(w.z << 16); f[5] = __uint_as_float(w.z & 0xffff0000u); f[6] = __uint_as_float(w.w << 16); f[7] = __uint_as_float(w.w & 0xffff0000u);
}

DEV void conv_tile(const float* W, int K, int N, bf16_t* WT, int mode, int tile, float* scr) {
    const int nkt = K >> 6; const int kt = tile % nkt, nt = tile / nkt, k0 = kt * 64, n0 = nt * 64, tid = otid();
#pragma unroll
    for (int e = 0; e < 8; ++e) { const int idx = e * 512 + tid, kk = idx >> 6, nn = idx & 63;
        const float v = (n0 + nn < N) ? W[(size_t)(k0 + kk) * N + n0 + nn] : 0.f; scr[nn * 65 + kk] = v; }
    __syncthreads();
    { const int nn = tid >> 3, c8 = tid & 7; const float* s = scr + nn * 65 + c8 * 8; const int n = n0 + nn;
      const int drow = mode == 0 ? n : ((n >> 7) * 256 + (n & 127) + (mode == 2 ? 128 : 0));
      u32x4 o; o.x = pk2(s[0], s[1]); o.y = pk2(s[2], s[3]); o.z = pk2(s[4], s[5]); o.w = pk2(s[6], s[7]);
      *(u32x4*)(WT + (size_t)drow * K + k0 + c8 * 8) = o; }
    __syncthreads();
}
DEV void convert_weights(PP p, int l, float* scr) {
    unsigned char* ws = p->ws;
    const int T_GU = 16 * 44, T_D = 44 * 16, T_IN = 16 * 60, T_OUT = 16 * 16;
    const int total = 4 * T_GU + 2 * T_D + T_IN + T_OUT;
    for (int it = blockIdx.x; it < total; it += gridDim.x) {
        int r = it;
        if (r < 4 * T_GU) { const int f = r / (2 * T_GU), which = (r / T_GU) & 1, t = r % T_GU;
            const float* W = p->in[which ? 3 : 2] + (size_t)(l * 2 + f) * DM * DFF;
            conv_tile(W, DM, DFF, (bf16_t*)(ws + WS_WGU + (size_t)f * 11 * MiB), which ? 2 : 1, t, scr); continue; }
        r -= 4 * T_GU;
        if (r < 2 * T_D) { const int f = r / T_D, t = r % T_D;
            conv_tile(p->in[4] + (size_t)(l * 2 + f) * DFF * DM, DFF, DM, (bf16_t*)(ws + WS_WD + (size_t)f * (11 * MiB / 2)), 0, t, scr); continue; }
        r -= 2 * T_D;
        if (r < T_IN) { conv_tile(p->in[5] + (size_t)l * DM * PT, DM, PT, (bf16_t*)(ws + WS_WIN), 0, r, scr); continue; }
        r -= T_IN;
        conv_tile(p->in[6] + (size_t)l * DM * DM, DM, DM, (bf16_t*)(ws + WS_WOUT), 0, r, scr);
    }
}
DEV void row_phase(const float* xin, float* xout, const bf16_t* d, const float* gA, float coef, const float* gB, bf16_t* xb) {
    const int tid_ = otid(); const int lane = tid_ & 63, gw = blockIdx.x * 8 + (tid_ >> 6), ngw = gridDim.x * 8;
    for (int row = gw; row < MR; row += ngw) {
        f32x4 v[4];
#pragma unroll
        for (int j = 0; j < 4; ++j) v[j] = ((const f32x4*)(xin + (size_t)row * DM))[lane + 64 * j];
        if (d) {
            f32x4 dv[4]; float ss = 0.f;
#pragma unroll
            for (int j = 0; j < 4; ++j) { const u32x2 w = ((const u32x2*)(d + (size_t)row * DM))[lane + 64 * j];
                dv[j][0] = __uint_as_float(w.x << 16); dv[j][1] = __uint_as_float(w.x & 0xffff0000u); dv[j][2] = __uint_as_float(w.y << 16); dv[j][3] = __uint_as_float(w.y & 0xffff0000u);
                ss += dv[j][0] * dv[j][0] + dv[j][1] * dv[j][1] + dv[j][2] * dv[j][2] + dv[j][3] * dv[j][3]; }
            const float rs = coef * rsqrtf(wave_sum(ss) * (1.f / DM) + RMS_EPS);
#pragma unroll
            for (int j = 0; j < 4; ++j) { const f32x4 g = ((const f32x4*)gA)[lane + 64 * j]; v[j] += dv[j] * g * rs; }
        }
#pragma unroll
        for (int j = 0; j < 4; ++j) ((f32x4*)(xout + (size_t)row * DM))[lane + 64 * j] = v[j];
        if (xb) {
            float ss = 0.f;
#pragma unroll
            for (int j = 0; j < 4; ++j) ss += v[j][0] * v[j][0] + v[j][1] * v[j][1] + v[j][2] * v[j][2] + v[j][3] * v[j][3];
            const float rs = rsqrtf(wave_sum(ss) * (1.f / DM) + RMS_EPS);
#pragma unroll
            for (int j = 0; j < 4; ++j) { const f32x4 g = ((const f32x4*)gB)[lane + 64 * j]; const f32x4 o = v[j] * g * rs;
                u32x2 w; w.x = pk2(o[0], o[1]); w.y = pk2(o[2], o[3]); ((u32x2*)(xb + (size_t)row * DM))[lane + 64 * j] = w; }
        }
    }
}
DEV f32x4 mm16(const float* A, int ars, int aks, const float* B, int bks, int bjs, int k_lo, int k_hi, f32x4 acc, int lane) {
    const int i = lane & 15, kq = lane >> 4;
    const float* ap = A + i * ars + kq * aks; const float* bp = B + kq * bks + i * bjs;
    for (int k0 = k_lo; k0 < k_hi; k0 += 4) acc = __builtin_amdgcn_mfma_f32_16x16x4f32(ap[k0 * aks], bp[k0 * bks], acc, 0, 0, 0);
    return acc;
}

constexpr int L_Q = 0, L_K = L_Q + 128 * 68, L_V = L_K + 128 * 68, L_S = L_V + 128 * 72, L_ST = L_S + 64 * 132, L_VEC = L_ST + 64 * 72, L_END = L_VEC + 9 * 128 + 64;
static_assert(L_END * 4 <= LDS_BYTES, "lds");
struct MixCtx { const bf16_t* z; const float* rope; float lg0, lg1, ib0, ib1, fb0, fb1; int mode; int b, h, c; };

DEV void mix_load_qkv(const MixCtx& m, float* lds, bool need_q) {
    const int tid = otid(), tok = tid >> 2, oct = tid & 3, t = m.c * CH + tok; const size_t row = (size_t)m.b * SEQ + t;
    const bf16_t* zr = m.z + row * ZLD + (m.mode == 0 ? 768 : 2752) + m.h * 64;
    float q1[8], q2[8], k1[8], k2[8], v1[8], v2[8];
    unpack8(*(const u32x4*)(zr + 256 + oct * 8), k1); unpack8(*(const u32x4*)(zr + 256 + 32 + oct * 8), k2);
    unpack8(*(const u32x4*)(zr + 512 + oct * 8), v1); unpack8(*(const u32x4*)(zr + 512 + 32 + oct * 8), v2);
    if (need_q) { unpack8(*(const u32x4*)(zr + oct * 8), q1); unpack8(*(const u32x4*)(zr + 32 + oct * 8), q2); }
    float* qs = lds + L_Q + tok * 68; float* ks = lds + L_K + tok * 68; float* vs = lds + L_V + tok * 72;
    if (m.mode == 0) {
        const float* cs = m.rope + (size_t)t * 32 + oct * 8; const float* sn = cs + SEQ * 32;
#pragma unroll
        for (int e = 0; e < 8; ++e) { const float c = cs[e], s = sn[e];
            const float ka = k1[e] * c - k2[e] * s, kb = k1[e] * s + k2[e] * c; ks[oct * 8 + e] = ka; ks[32 + oct * 8 + e] = kb;
            if (need_q) { const float qa = (q1[e] * c - q2[e] * s) * 0.125f, qb = (q1[e] * s + q2[e] * c) * 0.125f; qs[oct * 8 + e] = qa; qs[32 + oct * 8 + e] = qb; } }
    } else {
#pragma unroll
        for (int e = 0; e < 8; ++e) { ks[oct * 8 + e] = k1[e]; ks[32 + oct * 8 + e] = k2[e];
            if (need_q) { qs[oct * 8 + e] = q1[e] * 0.125f; qs[32 + oct * 8 + e] = q2[e] * 0.125f; } }
    }
#pragma unroll
    for (int e = 0; e < 8; ++e) { vs[oct * 8 + e] = v1[e]; vs[32 + oct * 8 + e] = v2[e]; }
}
DEV void mix_vectors(const MixCtx& m, float* lds, int d, float m_prev) {
    float* V = lds + L_VEC; const int tid = otid();
    if (m.mode == 0) {
        if (tid < 128) { const float lg = d == 0 ? m.lg0 : m.lg1;
            V[0 * 128 + tid] = d == 0 ? __expf((tid + 1) * lg) : __expf((128 - tid) * lg);
            V[1 * 128 + tid] = d == 0 ? __expf((127 - tid) * lg) : __expf(tid * lg); }
        __syncthreads();
        return;
    }
    if (tid < 128) { const size_t row = (size_t)m.b * SEQ + m.c * CH + tid; const bf16_t* zr = m.z + row * ZLD;
        const float li = bf2f(zr[3776 + d * 4 + m.h]) + (d == 0 ? m.ib0 : m.ib1); const float xf = bf2f(zr[3784 + d * 4 + m.h]) + (d == 0 ? m.fb0 : m.fb1);
        V[6 * 128 + tid] = li; V[7 * 128 + tid] = fminf(xf, 0.f) - log1pf(__expf(-fabsf(xf))); }
    __syncthreads();
    if (tid == 0) {
        float bc = 0.f, gm = -3.0e38f;
        if (d == 0) { for (int s = 0; s < 128; ++s) { bc += V[7 * 128 + s]; V[7 * 128 + s] = bc; const float g = V[6 * 128 + s] - bc; V[2 * 128 + s] = g; gm = fmaxf(gm, g); V[3 * 128 + s] = gm; } }
        else { for (int s = 127; s >= 0; --s) { bc += V[7 * 128 + s]; V[7 * 128 + s] = bc; const float g = V[6 * 128 + s] - bc; V[2 * 128 + s] = g; gm = fmaxf(gm, g); V[3 * 128 + s] = gm; } }
        V[8 * 128 + 0] = bc; V[8 * 128 + 1] = gm;
    }
    __syncthreads();
    if (tid < 128) { const float gmax_t = V[3 * 128 + tid], Mt = fmaxf(m_prev, gmax_t), bt = V[7 * 128 + tid];
        const float gend = V[8 * 128 + 1];
        V[0 * 128 + tid] = __expf(m_prev - Mt); V[4 * 128 + tid] = __expf(-(bt + Mt)); V[1 * 128 + tid] = __expf(V[2 * 128 + tid] - gend);
        V[3 * 128 + tid] = Mt; }
    __syncthreads();
}
DEV void mix_passA(const MixCtx& m, float* lds, float* states, float* nst, float* sst) {
    const int tid = otid(), lane = tid & 63, wave = __builtin_amdgcn_readfirstlane(tid >> 6);
    mix_load_qkv(m, lds, false);
    __syncthreads();
    for (int d = 0; d < 2; ++d) {
        mix_vectors(m, lds, d, 0.f);
        const float* wst = lds + L_VEC + 128; const float* ks = lds + L_K; const float* vs = lds + L_V;
        const size_t slot = ((size_t)((m.b * NH + m.h) * 2 + d)) * NCH + m.c;
        float* st = states + slot * 4096;
#pragma unroll
        for (int q = 0; q < 2; ++q) { const int id = wave + 8 * q, rt = id >> 2, ct = id & 3; const int i = lane & 15, kq = lane >> 4;
            f32x4 acc = {0.f, 0.f, 0.f, 0.f};
            for (int k0 = 0; k0 < 128; k0 += 4) { const int s = k0 + kq; acc = __builtin_amdgcn_mfma_f32_16x16x4f32(ks[s * 68 + 16 * rt + i] * wst[s], vs[s * 72 + 16 * ct + i], acc, 0, 0, 0); }
#pragma unroll
            for (int r = 0; r < 4; ++r) st[(16 * rt + kq * 4 + r) * 64 + 16 * ct + i] = acc[r]; }
        if (m.mode == 1) {
            if (tid < 64) { float a = 0.f; for (int s = 0; s < 128; ++s) a += wst[s] * ks[s * 68 + tid]; nst[slot * 64 + tid] = a; }
            if (tid == 64) { const float* V = lds + L_VEC; sst[slot] = V[8 * 128 + 0]; sst[4096 + slot] = V[8 * 128 + 0] + V[8 * 128 + 1]; }
        }
        __syncthreads();
    }
}
DEV void mix_passC(const MixCtx& m, float* lds, const float* states, const float* nst, const float* sst, bf16_t* Y, const float* norm_w) {
    const int tid = otid(), lane = tid & 63, wave = __builtin_amdgcn_readfirstlane(tid >> 6), i16 = lane & 15, kq = lane >> 4;
    f32x4 oacc[4];
#pragma unroll
    for (int a = 0; a < 4; ++a) oacc[a] = (f32x4){0.f, 0.f, 0.f, 0.f};
    mix_load_qkv(m, lds, true);
    __syncthreads();
    float* V = lds + L_VEC; float* qs = lds + L_Q; float* ks = lds + L_K; float* vs = lds + L_V; float* Sh = lds + L_S; float* St = lds + L_ST;
    for (int d = 0; d < 2; ++d) {
        const size_t slot = ((size_t)((m.b * NH + m.h) * 2 + d)) * NCH + m.c;
        const float m_prev = m.mode == 1 ? sst[8192 + slot] : 0.f;
        { const float* st = states + slot * 4096;
#pragma unroll
          for (int e = 0; e < 8; ++e) { const int idx = e * 512 + tid; St[(idx >> 6) * 72 + (idx & 63)] = st[idx]; }
          if (m.mode == 1 && tid < 64) V[9 * 128 + tid] = nst[slot * 64 + tid]; }
        mix_vectors(m, lds, d, m_prev);
        const float lg = d == 0 ? m.lg0 : m.lg1;
        for (int hf = 0; hf < 2; ++hf) {
#pragma unroll
            for (int q = 0; q < 4; ++q) { const int id = wave + 8 * q, rt = id >> 3, ct = id & 7; const int tr = 64 * hf + 16 * rt, sc = 16 * ct;
                const bool masked = d == 0 ? (sc > tr + 15) : (sc + 15 < tr);
                f32x4 acc = {0.f, 0.f, 0.f, 0.f};
                if (!masked) {
                    acc = mm16(qs + tr * 68, 68, 1, ks + sc * 68, 1, 68, 0, 64, acc, lane);
                    const int s = sc + i16;
#pragma unroll
                    for (int r = 0; r < 4; ++r) { const int t = tr + kq * 4 + r; float w;
                        if (m.mode == 0) { w = d == 0 ? (s <= t ? __expf((float)(t - s) * lg) : 0.f) : (s > t ? __expf((float)(s - t) * lg) : 0.f); }
                        else { const bool ok = d == 0 ? (s <= t) : (s >= t); w = ok ? __expf(V[2 * 128 + s] - V[3 * 128 + t]) : 0.f; }
                        acc[r] *= w; } }
#pragma unroll
                for (int r = 0; r < 4; ++r) Sh[(16 * rt + kq * 4 + r) * 132 + sc + i16] = acc[r]; }
            __syncthreads();
            if (m.mode == 1) { const int row = tid >> 3, seg = tid & 7, t = 64 * hf + row; float a = 0.f;
#pragma unroll
                for (int e = 0; e < 16; ++e) a += Sh[row * 132 + seg * 16 + e];
                float qn = 0.f;
#pragma unroll
                for (int e = 0; e < 8; ++e) qn += qs[t * 68 + seg * 8 + e] * V[9 * 128 + seg * 8 + e];
                a += V[0 * 128 + t] * qn;
                a += __shfl_xor(a, 1); a += __shfl_xor(a, 2); a += __shfl_xor(a, 4);
                if (seg == 0) V[5 * 128 + t] = a;
                __syncthreads(); }
#pragma unroll
            for (int q = 0; q < 2; ++q) { const int id = wave + 8 * q, rt = id >> 2, ct = id & 3; const int tr = 64 * hf + 16 * rt;
                const int k_lo = d == 0 ? 0 : tr, k_hi = d == 0 ? tr + 16 : 128;
                f32x4 intra = {0.f, 0.f, 0.f, 0.f}, inter = {0.f, 0.f, 0.f, 0.f};
                intra = mm16(Sh + 16 * rt * 132, 132, 1, vs + 16 * ct, 72, 1, k_lo, k_hi, intra, lane);
                inter = mm16(qs + tr * 68, 68, 1, St + 16 * ct, 72, 1, 0, 64, inter, lane);
#pragma unroll
                for (int r = 0; r < 4; ++r) { const int t = tr + kq * 4 + r; float val = intra[r] + V[0 * 128 + t] * inter[r];
                    if (m.mode == 1) val = val / fmaxf(fabsf(V[5 * 128 + t]), V[4 * 128 + t]);
                    oacc[hf * 2 + q][r] += val; } }
            __syncthreads();
        }
    }
    float* os = lds + L_S;
#pragma unroll
    for (int hf = 0; hf < 2; ++hf)
#pragma unroll
        for (int q = 0; q < 2; ++q) { const int id = wave + 8 * q, rt = id >> 2, ct = id & 3; const int tr = 64 * hf + 16 * rt;
#pragma unroll
            for (int r = 0; r < 4; ++r) os[(tr + kq * 4 + r) * 66 + 16 * ct + i16] = oacc[hf * 2 + q][r]; }
    __syncthreads();
    { const int tok = tid >> 2, qd = tid & 3; const size_t row = (size_t)m.b * SEQ + m.c * CH + tok; float o[16]; float ss = 0.f;
#pragma unroll
      for (int e = 0; e < 16; ++e) { o[e] = os[tok * 66 + qd * 16 + e]; ss += o[e] * o[e]; }
      ss += __shfl_xor(ss, 1); ss += __shfl_xor(ss, 2);
      const float rs = rsqrtf(ss * (1.f / 64.f) + RMS_EPS);
      const bf16_t* zg = m.z + row * ZLD + (m.mode == 0 ? 1536 : 3520) + m.h * 64 + qd * 16;
      float g[16]; unpack8(*(const u32x4*)zg, g); unpack8(*(const u32x4*)(zg + 8), g + 8);
      float y[16];
#pragma unroll
      for (int e = 0; e < 16; ++e) { const float gate = m.mode == 0 ? g[e] * sigmoid_f(g[e]) : sigmoid_f(g[e]) * norm_w[m.h * 64 + qd * 16 + e]; y[e] = o[e] * rs * gate; }
      u32x4 w0, w1; w0.x = pk2(y[0], y[1]); w0.y = pk2(y[2], y[3]); w0.z = pk2(y[4], y[5]); w0.w = pk2(y[6], y[7]);
      w1.x = pk2(y[8], y[9]); w1.y = pk2(y[10], y[11]); w1.z = pk2(y[12], y[13]); w1.w = pk2(y[14], y[15]);
      bf16_t* yp = Y + row * DM + (m.mode == 0 ? 256 : 768) + m.h * 64 + qd * 16;
      *(u32x4*)yp = w0; *(u32x4*)(yp + 8) = w1; }
    __syncthreads();
}

DEV void mix_passB(PP p, int l) {
    float* rs = (float*)(p->ws + WS_RET); float* mc = (float*)(p->ws + WS_MLC); float* mn = (float*)(p->ws + WS_MLN); float* ms = (float*)(p->ws + WS_MLS);
    const float* dl = p->in[9] + l * 8;
    const int gt = blockIdx.x * 512 + otid(), ngt = gridDim.x * 512;
    for (int e = gt; e < 32 * 4096; e += ngt) {
        const int seq = e >> 12, el = e & 4095, d = seq & 1, h = (seq >> 1) & 3;
        {
            const float x = dl[d * 4 + h]; const float lg = fminf(x, 0.f) - log1pf(__expf(-fabsf(x))); const float dec = __expf(128.f * lg);
            float F = 0.f; float* base = rs + (size_t)seq * NCH * 4096 + el;
#pragma unroll 8
            for (int i = 0; i < NCH; ++i) { const int c = d ? NCH - 1 - i : i; const float loc = base[(size_t)c * 4096]; base[(size_t)c * 4096] = F; F = dec * F + loc; }
        }
        {
            float C = 0.f, nn = 0.f, mm = 0.f; float* base = mc + (size_t)seq * NCH * 4096 + el; float* nb = mn + (size_t)seq * NCH * 64 + (el & 63);
#pragma unroll 4
            for (int i = 0; i < NCH; ++i) { const int c = d ? NCH - 1 - i : i; const int slot = seq * NCH + c;
                const float bend = ms[slot], mloc = ms[4096 + slot];
                const float mnew = fmaxf(bend + mm, mloc), so = __expf(bend + mm - mnew), sn = __expf(mloc - mnew);
                const float loc = base[(size_t)c * 4096]; base[(size_t)c * 4096] = C; C = so * C + sn * loc;
                if (el < 64) { const float nl = nb[(size_t)c * 64]; nb[(size_t)c * 64] = nn; nn = so * nn + sn * nl; }
                if (el == 0) ms[8192 + slot] = mm;
                mm = mnew; }
        }
    }
}
DEV void conv_mixer(PP p, int l, const bf16_t* z, bf16_t* Y) {
    const float* cw = p->in[7] + l * 768; const float* cb = p->in[8] + l * 256;
    const int gt = blockIdx.x * 512 + otid(), ngt = gridDim.x * 512;
    for (int it = gt; it < MR * 32; it += ngt) {
        const int row = it >> 5, c8 = (it & 31) * 8, t = row & (SEQ - 1); const bf16_t* zr = z + (size_t)row * ZLD;
        float gb[8], a[8], b[8], up[8], un[8], u[8];
        unpack8(*(const u32x4*)(zr + c8), gb); unpack8(*(const u32x4*)(zr + 256 + c8), a); unpack8(*(const u32x4*)(zr + 512 + c8), b);
#pragma unroll
        for (int e = 0; e < 8; ++e) { u[e] = a[e] * b[e]; up[e] = 0.f; un[e] = 0.f; }
        if (t > 0) { unpack8(*(const u32x4*)(zr - ZLD + 256 + c8), a); unpack8(*(const u32x4*)(zr - ZLD + 512 + c8), b);
#pragma unroll
            for (int e = 0; e < 8; ++e) up[e] = a[e] * b[e]; }
        if (t < SEQ - 1) { unpack8(*(const u32x4*)(zr + ZLD + 256 + c8), a); unpack8(*(const u32x4*)(zr + ZLD + 512 + c8), b);
#pragma unroll
            for (int e = 0; e < 8; ++e) un[e] = a[e] * b[e]; }
        float y[8];
#pragma unroll
        for (int e = 0; e < 8; ++e) y[e] = gb[e] * (up[e] * cw[c8 + e] + u[e] * cw[256 + c8 + e] + un[e] * cw[512 + c8 + e] + cb[c8 + e]);
        u32x4 w; w.x = pk2(y[0], y[1]); w.y = pk2(y[2], y[3]); w.z = pk2(y[4], y[5]); w.w = pk2(y[6], y[7]);
        *(u32x4*)(Y + (size_t)row * DM + c8) = w;
    }
}

DEV float rw_shift(const bf16_t* z, size_t row, int t, int col, const float* mu) {
    const bf16_t* zr = z + row * ZLD + 1792 + col; const float x = bf2f(zr[0]);
    const float pv = t > 0 ? bf2f(zr[-ZLD]) : 0.f, nx = t < SEQ - 1 ? bf2f(zr[ZLD]) : 0.f;
    return x + mu[col] * (0.5f * (pv + nx) - x);
}
struct RwCtx { const bf16_t* z; const float *mu, *w0, *w2, *a0, *a2, *k_k, *k_a, *r_k; float* sbon; int b, c, d; };
template <int PASS> DEV void rw_prep(const RwCtx& R, float* ops, float* latw, int sb, int bi, int hp, int lane) {
    const int ch = hp * 64 + lane, d = R.d;
    float rr[RW_T], kx[RW_T], vx[RW_T], accw[RW_T], acca[RW_T];
#pragma unroll
    for (int j = 0; j < RW_T; ++j) { const int jj = d == 0 ? sb * RW_T + j : RW_LC - 1 - (sb * RW_T + j); const int t = R.c * RW_LC + jj; const size_t row = (size_t)R.b * SEQ + t;
        rr[j] = rw_shift(R.z, row, t, ch, R.mu); kx[j] = rw_shift(R.z, row, t, 256 + ch, R.mu); vx[j] = rw_shift(R.z, row, t, 512 + ch, R.mu);
        const int lc = lane < 32 ? 768 + d * 32 + lane : 832 + d * 32 + (lane - 32);
        float lv = rw_shift(R.z, row, t, lc, R.mu); if (lane < 32) lv = tanhf(lv);
        latw[j * 64 + lane] = lv; accw[j] = 0.f; acca[j] = 0.f; }
    asm volatile("s_waitcnt lgkmcnt(0)" ::: "memory");
    for (int r = 0; r < 32; ++r) { const float w2v = R.w2[(d * 32 + r) * 256 + ch], a2v = R.a2[(d * 32 + r) * 256 + ch];
#pragma unroll
        for (int j = 0; j < RW_T; ++j) { accw[j] += latw[j * 64 + r] * w2v; acca[j] += latw[j * 64 + 32 + r] * a2v; } }
    const float w0v = R.w0[d * 256 + ch], a0v = R.a0[d * 256 + ch], kkw = R.k_k[ch], kaw = R.k_a[ch], rkw = R.r_k[ch];
#pragma unroll
    for (int j = 0; j < RW_T; ++j) {
        const float wlog = -softplus_f(-(w0v + accw[j])) - 0.5f; const float decay = __expf(-__expf(wlog));
        const float a = sigmoid_f(a0v + acca[j]);
        const float kkv = kx[j] * kkw; const float ss = wave_sum(kkv * kkv); const float kkn = kkv / fmaxf(sqrtf(ss), 1e-12f);
        const float kd = kx[j] * (1.f + (a - 1.f) * kaw);
        float* o = ops + ((bi * 4 + hp) * RW_T + j) * 384;
        o[lane] = decay; o[64 + lane] = kkn * a; o[128 + lane] = kd; o[192 + lane] = -kkn; o[256 + lane] = rr[j]; o[320 + lane] = vx[j];
        if (PASS == 2) { const float sbv = wave_sum(rr[j] * kd * rkw);
            const int jj = d == 0 ? sb * RW_T + j : RW_LC - 1 - (sb * RW_T + j); const size_t row = (size_t)R.b * SEQ + R.c * RW_LC + jj;
            if (lane == 0) R.sbon[((size_t)d * MR + row) * 4 + hp] = sbv; }
    }
}
template <int PASS> DEV void rw_task(PP p, int l, int task, float* lds) {
    const int tid = otid(), wave = __builtin_amdgcn_readfirstlane(tid >> 6), lane = tid & 63;
    RwCtx R; R.z = (const bf16_t*)(p->ws + WS_BIG); R.mu = p->in[10] + l * 960; R.w0 = p->in[11] + l * 512; R.w2 = p->in[12] + l * 16384; R.a0 = p->in[13] + l * 512; R.a2 = p->in[14] + l * 16384;
    R.k_k = p->in[16] + l * 256; R.k_a = p->in[17] + l * 256; R.r_k = p->in[18] + l * 256; R.sbon = (float*)(p->ws + WS_SBON);
    R.d = task & 1; R.c = (task >> 1) & (RW_NC - 1); R.b = task >> 6;
    float* ops = lds; float* latw = lds + 2 * 4 * RW_T * 384 + (wave & 3) * RW_T * 64;
    float* pe = (float*)(p->ws + WS_PE); float* wkv = (float*)(p->ws + WS_WKV);
    const int h = wave & 3; const int chain = (R.b * NH + h) * 2 + R.d; const int sc = R.d == 0 ? R.c : RW_NC - 1 - R.c;
    float* slot = pe + ((size_t)chain * RW_NC + sc) * 8192;
    if (wave >= 4) {
        rw_prep<PASS>(R, ops, latw, 0, 0, wave - 4, lane);
        __syncthreads();
#pragma unroll 1
        for (int sb = 0; sb < RW_LC / RW_T; ++sb) {
            if (sb + 1 < RW_LC / RW_T) rw_prep<PASS>(R, ops, latw, sb + 1, (sb + 1) & 1, wave - 4, lane);
            __syncthreads();
        }
        return;
    }
    f32x2 S[32], P[32];
    if (PASS == 1) {
#pragma unroll
        for (int k = 0; k < 32; ++k) { S[k] = (f32x2){0.f, 0.f}; P[k] = (f32x2){(2 * k == lane) ? 1.f : 0.f, (2 * k + 1 == lane) ? 1.f : 0.f}; }
    } else {
#pragma unroll
        for (int k = 0; k < 16; ++k) { const f32x4 v = *(const f32x4*)(slot + 4096 + lane * 64 + 4 * k); S[2 * k] = (f32x2){v[0], v[1]}; S[2 * k + 1] = (f32x2){v[2], v[3]};
            P[2 * k] = (f32x2){0.f, 0.f}; P[2 * k + 1] = (f32x2){0.f, 0.f}; }
    }
    __syncthreads();
#pragma unroll 1
    for (int sb = 0; sb < RW_LC / RW_T; ++sb) {
#pragma unroll 1
        for (int j = 0; j < RW_T; ++j) {
            const float* o = ops + (((sb & 1) * 4 + h) * RW_T + j) * 384;
            const float vv = o[320 + lane];
            f32x2 sa2 = {0.f, 0.f}, sp2 = {0.f, 0.f};
#pragma unroll
            for (int k = 0; k < 16; ++k) { const f32x4 nk = *(const f32x4*)(o + 192 + 4 * k); const f32x2 n0 = {nk[0], nk[1]}, n1 = {nk[2], nk[3]};
                sa2 += S[2 * k] * n0; sa2 += S[2 * k + 1] * n1;
                if (PASS == 1) { sp2 += P[2 * k] * n0; sp2 += P[2 * k + 1] * n1; } }
            const float sa = sa2[0] + sa2[1], sp = sp2[0] + sp2[1];
            const f32x2 sav = {sa, sa}, spv = {sp, sp}, vvv = {vv, vv};
            f32x2 y2 = {0.f, 0.f};
#pragma unroll
            for (int k = 0; k < 16; ++k) { const f32x4 w4 = *(const f32x4*)(o + 4 * k), b4 = *(const f32x4*)(o + 64 + 4 * k), k4 = *(const f32x4*)(o + 128 + 4 * k);
                const f32x2 w0 = {w4[0], w4[1]}, w1 = {w4[2], w4[3]}, b0 = {b4[0], b4[1]}, b1 = {b4[2], b4[3]}, d0 = {k4[0], k4[1]}, d1 = {k4[2], k4[3]};
                S[2 * k] = S[2 * k] * w0 + sav * b0 + vvv * d0; S[2 * k + 1] = S[2 * k + 1] * w1 + sav * b1 + vvv * d1;
                if (PASS == 1) { P[2 * k] = P[2 * k] * w0 + spv * b0; P[2 * k + 1] = P[2 * k + 1] * w1 + spv * b1; }
                if (PASS == 2) { const f32x4 r4 = *(const f32x4*)(o + 256 + 4 * k); const f32x2 r0 = {r4[0], r4[1]}, r1 = {r4[2], r4[3]}; y2 += S[2 * k] * r0; y2 += S[2 * k + 1] * r1; } }
            if (PASS == 2) { const int jj = R.d == 0 ? sb * RW_T + j : RW_LC - 1 - (sb * RW_T + j); const size_t row = (size_t)R.b * SEQ + R.c * RW_LC + jj;
                wkv[((size_t)R.d * MR + row) * 256 + h * 64 + lane] = y2[0] + y2[1]; }
        }
        __syncthreads();
    }
    if (PASS == 1) {
#pragma unroll
        for (int k = 0; k < 16; ++k) { *(f32x4*)(slot + lane * 64 + 4 * k) = (f32x4){P[2 * k][0], P[2 * k][1], P[2 * k + 1][0], P[2 * k + 1][1]};
            *(f32x4*)(slot + 4096 + lane * 64 + 4 * k) = (f32x4){S[2 * k][0], S[2 * k][1], S[2 * k + 1][0], S[2 * k + 1][1]}; }
    }
}
DEV void rw_passB(PP p, float* lds) {
    const int tid = otid(), wave = __builtin_amdgcn_readfirstlane(tid >> 6), lane = tid & 63, i16 = lane & 15, kq = lane >> 4;
    float* Sl = lds; float* Pl = lds + 64 * 68; float* pe = (float*)(p->ws + WS_PE);
    for (int chain = blockIdx.x; chain < 32; chain += gridDim.x) {
#pragma unroll
        for (int e = 0; e < 8; ++e) { const int idx = e * 512 + tid; Sl[(idx >> 6) * 68 + (idx & 63)] = 0.f; }
        __syncthreads();
        for (int sc = 0; sc < RW_NC; ++sc) {
            float* slot = pe + ((size_t)chain * RW_NC + sc) * 8192;
#pragma unroll
            for (int e = 0; e < 8; ++e) { const int idx = e * 512 + tid; Pl[(idx >> 6) * 72 + (idx & 63)] = slot[idx]; }
            __syncthreads();
            f32x4 acc[2];
#pragma unroll
            for (int q = 0; q < 2; ++q) { const int id = wave + 8 * q, rt = id >> 2, ct = id & 3;
#pragma unroll
                for (int r = 0; r < 4; ++r) { const int row = 16 * rt + kq * 4 + r, col = 16 * ct + i16; acc[q][r] = slot[4096 + row * 64 + col]; }
                acc[q] = mm16(Sl + 16 * rt * 68, 68, 1, Pl + 16 * ct, 72, 1, 0, 64, acc[q], lane);
#pragma unroll
                for (int r = 0; r < 4; ++r) { const int row = 16 * rt + kq * 4 + r, col = 16 * ct + i16; slot[4096 + row * 64 + col] = Sl[row * 68 + col]; } }
            __syncthreads();
#pragma unroll
            for (int q = 0; q < 2; ++q) { const int id = wave + 8 * q, rt = id >> 2, ct = id & 3;
#pragma unroll
                for (int r = 0; r < 4; ++r) Sl[(16 * rt + kq * 4 + r) * 68 + 16 * ct + i16] = acc[q][r]; }
            __syncthreads();
        }
    }
}
DEV void rw_final(PP p, int l, float* lds) {
    const int tid = otid(), tg = tid >> 8, c = tid & 255, h = c >> 6;
    const bf16_t* z = (const bf16_t*)(p->ws + WS_BIG); bf16_t* Y = (bf16_t*)(p->ws + WS_XB);
    const float* mu = p->in[10] + l * 960; const float* g2 = p->in[15] + l * 16384; const float* wkv = (const float*)(p->ws + WS_WKV); const float* sbon = (const float*)(p->ws + WS_SBON);
    const float lnw = p->in[19][l * 256 + c], lnb = p->in[20][l * 256 + c];
    float g2r[64];
#pragma unroll
    for (int r = 0; r < 64; ++r) g2r[r] = g2[r * 256 + c];
    float* sgl = lds;
    for (int tile = blockIdx.x; tile < MR / 32; tile += gridDim.x) {
        const int row0 = tile * 32;
#pragma unroll
        for (int e = 0; e < 4; ++e) { const int idx = e * 512 + tid, tok = idx >> 6, r = idx & 63; const int row = row0 + tok;
            sgl[tok * 64 + r] = sigmoid_f(rw_shift(z, row, row & (SEQ - 1), 896 + r, mu)); }
        __syncthreads();
        for (int q = 0; q < 16; ++q) { const int tok = tg * 16 + q; const size_t row = row0 + tok; const int t = (int)(row & (SEQ - 1));
            float gate = 0.f;
#pragma unroll
            for (int r = 0; r < 64; ++r) gate += sgl[tok * 64 + r] * g2r[r];
            const float wk = wkv[row * 256 + c] + wkv[((size_t)MR + row) * 256 + c];
            const float mean = wave_sum(wk) * (1.f / 64.f); const float dv = wk - mean; const float var = wave_sum(dv * dv) * (1.f / 64.f);
            const float nrm = dv * rsqrtf(var + 64e-5f);
            const float vsh = rw_shift(z, row, t, 512 + c, mu);
            const float bon = (sbon[row * 4 + h] + sbon[((size_t)MR + row) * 4 + h]) * vsh;
            const float out = (nrm * lnw + lnb + bon) * gate;
            Y[row * DM + 512 + c] = (bf16_t)f2bf(out); }
        __syncthreads();
    }
}

DEV void mix_items(PP p, int l, int pass, float* ldsf) {
    unsigned char* ws = p->ws; const bf16_t* BIG = (const bf16_t*)(ws + WS_BIG); bf16_t* XB = (bf16_t*)(ws + WS_XB);
    for (int it = blockIdx.x; it < 2 * NB * NH * NCH; it += gridDim.x) { MixCtx m; const int mode = it >= NB * NH * NCH; const int r = it - mode * NB * NH * NCH;
        m.mode = mode; m.z = BIG; m.rope = (const float*)(ws + WS_ROPE); m.b = r / (NH * NCH); m.h = (r / NCH) % NH; m.c = r % NCH;
        { const float x0 = p->in[9][l * 8 + m.h], x1 = p->in[9][l * 8 + 4 + m.h];
          m.lg0 = fminf(x0, 0.f) - log1pf(__expf(-fabsf(x0))); m.lg1 = fminf(x1, 0.f) - log1pf(__expf(-fabsf(x1)));
          m.ib0 = p->in[21][l * 8 + m.h]; m.ib1 = p->in[21][l * 8 + 4 + m.h]; m.fb0 = p->in[22][l * 8 + m.h]; m.fb1 = p->in[22][l * 8 + 4 + m.h]; }
        if (pass == 0) mix_passA(m, ldsf, (float*)(ws + (mode ? WS_MLC : WS_RET)), (float*)(ws + WS_MLN), (float*)(ws + WS_MLS));
        else mix_passC(m, ldsf, (const float*)(ws + (mode ? WS_MLC : WS_RET)), (const float*)(ws + WS_MLN), (const float*)(ws + WS_MLS), XB, p->in[23] + l * 256); }
}
__global__ void __launch_bounds__(512, 2) mega_fwd(Params pdummy) {
    extern __shared__ __attribute__((aligned(16))) unsigned char lds_raw[];
    cg::grid_group grid = cg::this_grid();
    float* ldsf = (float*)lds_raw; PG8_LAS unsigned char* ldsg = (PG8_LAS unsigned char*)lds_raw;
    { PP p = fresh_params(); unsigned char* ws = p->ws;
      convert_weights(p, 0, ldsf);
      float* rope = (float*)(ws + WS_ROPE); const int tid = otid();
      for (int i = blockIdx.x * 512 + tid; i < SEQ * 32; i += gridDim.x * 512) { const int t = i >> 5, k = i & 31;
          const float inv = powf(10000.f, -(float)(2 * k) / 64.f); const float ang = (float)t * inv;
          const double ad = (double)ang; const double rev = ad * 0.15915494309189535; const double fr = rev - rint(rev); const float rr = (float)(fr * 6.283185307179586);
          (void)rr; rope[i] = __builtin_amdgcn_cosf((float)fr); rope[SEQ * 32 + i] = __builtin_amdgcn_sinf((float)fr); }
      row_phase(p->in[0], p->out, nullptr, nullptr, 0.f, p->in[1], (bf16_t*)(ws + WS_XB)); }
    grid.sync();
    for (int ph = 0; ph < 26; ++ph) {
        const int phu = __builtin_amdgcn_readfirstlane(ph);
        const int l = phu >= 13 ? 1 : 0, k = phu - 13 * l;
        PP p = fresh_params(); unsigned char* ws = p->ws; const int G = gridDim.x;
        bf16_t* XB = (bf16_t*)(ws + WS_XB); bf16_t* BIG = (bf16_t*)(ws + WS_BIG); bf16_t* DB = (bf16_t*)(ws + WS_D);
        const float* g = p->in[1] + (size_t)l * 6 * DM;
        if (k == 0 || k == 10) {
            const int f = k == 10;
            pg8::Gemm gm{XB, (const bf16_t*)(ws + WS_WGU + (size_t)f * 11 * MiB), MR, 2 * DFF, DM}; pg8::StaticOrder S; S.init(MR, 2 * DFF, G, (int)blockIdx.x); pg8::EpiSwiGLU E{BIG, DFF};
            pg8::gemm_phase<pg8::EpiSwiGLU, pg8::StaticOrder, true, true>(ldsg, gm, S, E);
        } else if (k == 1 || k == 11 || k == 3 || k == 8) {
            const bf16_t* A; const bf16_t* Bt; bf16_t* O; int N, K;
            if (k == 3) { A = XB; Bt = (const bf16_t*)(ws + WS_WIN); O = BIG; N = ZLD; K = DM; }
            else if (k == 8) { A = XB; Bt = (const bf16_t*)(ws + WS_WOUT); O = DB; N = DM; K = DM; }
            else { A = BIG; Bt = (const bf16_t*)(ws + WS_WD + (size_t)(k == 11) * (11 * MiB / 2)); O = DB; N = DM; K = DFF; }
            pg8::Gemm gm{A, Bt, MR, N, K}; pg8::StaticOrder S; S.init(MR, N, G, (int)blockIdx.x); pg8::EpiBf16 E{O, N};
            pg8::gemm_phase<pg8::EpiBf16, pg8::StaticOrder, true, true>(ldsg, gm, S, E);
        } else if (k == 2) { row_phase(p->out, p->out, DB, g + 1 * DM, 0.5f, g + 2 * DM, XB);
        } else if (k == 9) { row_phase(p->out, p->out, DB, g + 3 * DM, 1.0f, g + 4 * DM, XB);
        } else if (k == 12) { row_phase(p->out, p->out, DB, g + 5 * DM, 0.5f, l == 0 ? g + 6 * DM : nullptr, l == 0 ? XB : nullptr);
            if (l == 0) convert_weights(p, 1, ldsf);
        } else if (k == 4) {
            for (int task = blockIdx.x; task < NB * RW_NC * 2; task += G) rw_task<1>(p, l, task, ldsf);
            __syncthreads();
            mix_items(p, l, 0, ldsf);
            conv_mixer(p, l, BIG, XB);
        } else if (k == 5) { rw_passB(p, ldsf); mix_passB(p, l);
        } else if (k == 6) {
            for (int task = blockIdx.x; task < NB * RW_NC * 2; task += G) rw_task<2>(p, l, task, ldsf);
            __syncthreads();
            mix_items(p, l, 1, ldsf);
        } else { rw_final(p, l, ldsf); }
        if (ph != 25) grid.sync();
    }
}

extern "C" void kernel_launch(void* const* d_in, const int* in_sizes, int n_in, void* d_out, int out_size, void* d_ws, size_t ws_size, hipStream_t stream) {
    static int grid = 0;
    if (grid == 0) {
        int dev = 0, cus = 0, per_cu = 0;
        (void)hipGetDevice(&dev); (void)hipDeviceGetAttribute(&cus, hipDeviceAttributeMultiprocessorCount, dev);
        (void)hipFuncSetAttribute((const void*)mega_fwd, hipFuncAttributeMaxDynamicSharedMemorySize, LDS_BYTES);
        (void)hipOccupancyMaxActiveBlocksPerMultiprocessor(&per_cu, (const void*)mega_fwd, 512, LDS_BYTES);
        if (per_cu < 1) fprintf(stderr, "occupancy query says %d blocks/CU\n", per_cu);
        (void)hipGetLastError();
        grid = cus;
        if (ws_size < WS_END) fprintf(stderr, "kernel_launch: workspace too small: %zu < %zu\n", ws_size, (size_t)WS_END);
    }
    Params p{};
    for (int i = 0; i < 24; ++i) p.in[i] = (const float*)d_in[i];
    p.out = (float*)d_out; p.ws = (unsigned char*)d_ws;
    void* args[] = {&p};
    hipError_t e = hipLaunchCooperativeKernel((const void*)mega_fwd, dim3(grid), dim3(512), args, LDS_BYTES, stream);
    if (e != hipSuccess) fprintf(stderr, "cooperative launch failed: %s (grid %d)\n", hipGetErrorString(e), grid);
}
```

```cpp
#include <hip/hip_runtime.h>
#include <hip/hip_cooperative_groups.h>
#include <cstdio>
#include <cstdint>
namespace cg = cooperative_groups;
namespace pg8 {
#define PG8_LAS __attribute__((address_space(3)))
typedef unsigned short bf16_t;
typedef short bf16x8 __attribute__((ext_vector_type(8)));
typedef float f32x4 __attribute__((ext_vector_type(4)));
typedef unsigned u32x4 __attribute__((ext_vector_type(4)));
constexpr int BM = 256, BK = 64, HALF = 128, HTB = HALF * BK * 2, STAGE_BYTES = 8 * HTB, NXCD = 8, WGM = 8;
__host__ __device__ __forceinline__ int lds_byte(int r, int c) { const int st = (r >> 4) * 2 + (c >> 5), rr = r & 15, cc = c & 31, ob = rr * 64 + cc * 2; return st * 1024 + (ob ^ (((ob >> 9) & 1) << 5)); }
__host__ __device__ __forceinline__ void stage_rc(int b, int& R, int& C) { const int st = b / 1024, sb = b % 1024, swz = sb ^ (((sb >> 9) & 1) << 5); R = (st >> 1) * 16 + swz / 64; C = (st & 1) * 32 + (swz % 64) / 2; }
__host__ __device__ __forceinline__ int perm32(int rho) { const int n = rho >> 4, i = rho & 15; return 8 * (i >> 2) + 4 * n + (i & 3); }
struct Unit { int pm, pn; };
struct Gemm { const bf16_t* A; const bf16_t* Bt; int M, N, K; };
struct StaticOrder {
    int nM, nN, nwg, G, c;
    __host__ __device__ void init(int M, int N, int G_, int c_) { nM = M / BM; nN = N / BM; nwg = nM * nN; G = G_; c = c_; }
    __host__ __device__ bool next(int i, Unit& u) const {
        const long L = (long)i * G + c; if (L >= nwg) return false;
        int wgid = (int)L; { const int q = nwg / NXCD, r = nwg % NXCD, xcd = wgid % NXCD, off = wgid / NXCD; wgid = (xcd < r ? xcd * (q + 1) : r * (q + 1) + (xcd - r) * q) + off; }
        const int nig = WGM * nN, gid = wgid / nig, fm = gid * WGM, gsz = (nM - fm) < WGM ? (nM - fm) : WGM;
        u.pm = fm + ((wgid % nig) % gsz); u.pn = (wgid % nig) / gsz; return true;
    }
    __device__ __forceinline__ void a_ready(const Unit&) const {}
    __device__ __forceinline__ void done(const Unit&) const {}
};
__device__ __forceinline__ unsigned cvt_pk_bf16(float lo, float hi) { unsigned r; asm volatile("v_cvt_pk_bf16_f32 %0, %1, %2" : "=v"(r) : "v"(lo), "v"(hi)); return r; }
struct EpiBf16 {
    static constexpr bool PERM = true, AFTER_DRAIN = false;
    bf16_t* O; int ldc;
    __device__ __forceinline__ void operator()(const f32x4 (&acc)[2][2][4][2], const Unit& u, int wr, int wc, int fr, int fq) const {
        const int row0 = u.pm * BM + wr * 64 + fr; const int col0 = u.pn * BM + wc * 32 + 8 * fq;
#pragma unroll
        for (int ai = 0; ai < 2; ++ai)
#pragma unroll
            for (int m = 0; m < 4; ++m) { bf16_t* rowp = O + (size_t)(row0 + ai * HALF + m * 16) * ldc + col0;
#pragma unroll
                for (int bj = 0; bj < 2; ++bj) { const f32x4 v0 = acc[ai][bj][m][0], v1 = acc[ai][bj][m][1];
                    u32x4 w; w.x = cvt_pk_bf16(v0[0], v0[1]); w.y = cvt_pk_bf16(v0[2], v0[3]); w.z = cvt_pk_bf16(v1[0], v1[1]); w.w = cvt_pk_bf16(v1[2], v1[3]);
                    *(u32x4*)(rowp + bj * HALF) = w; } }
    }
};
__device__ __forceinline__ float silu_f(float g) { return g * __builtin_amdgcn_rcpf(1.0f + __expf(-g)); }
struct EpiSwiGLU {
    static constexpr bool PERM = true, AFTER_DRAIN = false;
    bf16_t* O; int ldc;
    __device__ __forceinline__ void operator()(const f32x4 (&acc)[2][2][4][2], const Unit& u, int wr, int wc, int fr, int fq) const {
        const int row0 = u.pm * BM + wr * 64 + fr; const int col0 = u.pn * HALF + wc * 32 + 8 * fq;
#pragma unroll
        for (int ai = 0; ai < 2; ++ai)
#pragma unroll
            for (int m = 0; m < 4; ++m) { bf16_t* rowp = O + (size_t)(row0 + ai * HALF + m * 16) * ldc + col0;
                const f32x4 g0 = acc[ai][0][m][0], g1 = acc[ai][0][m][1], u0 = acc[ai][1][m][0], u1 = acc[ai][1][m][1];
                u32x4 w;
                w.x = cvt_pk_bf16(silu_f(g0[0]) * u0[0], silu_f(g0[1]) * u0[1]); w.y = cvt_pk_bf16(silu_f(g0[2]) * u0[2], silu_f(g0[3]) * u0[3]);
                w.z = cvt_pk_bf16(silu_f(g1[0]) * u1[0], silu_f(g1[1]) * u1[1]); w.w = cvt_pk_bf16(silu_f(g1[2]) * u1[2], silu_f(g1[3]) * u1[3]);
                *(u32x4*)rowp = w; }
    }
};
template <class Epi, class Sched, bool ALIGN_EPI = false, bool SP2 = false>
__device__ __forceinline__ void gemm_phase(PG8_LAS unsigned char* lds, const Gemm g, const Sched& S, const Epi& E) {
    int tid = threadIdx.x; asm volatile("" : "+v"(tid)); const int wid = __builtin_amdgcn_readfirstlane(tid >> 6), lane = tid & 63, wr = wid >> 2, wc = wid & 3, fr = lane & 15, fq = lane >> 4;
    const int K = g.K, nt = K / BK;
    unsigned voffA[2], voffB[2];
#pragma unroll
    for (int i = 0; i < 2; ++i) { int R, C; stage_rc(tid * 16 + i * 8192, R, C); const int Rb = Epi::PERM ? ((R & ~31) + perm32(R & 31)) : R;
        voffA[i] = (unsigned)(R * K + C) * 2u; voffB[i] = (unsigned)(Rb * K + C) * 2u; }
    const size_t kstep = (size_t)(BK * 2);
    const size_t hstep = (size_t)HALF * K * 2;
    const size_t tstep = 2 * hstep;
    const unsigned ldsw = (unsigned)wid * 1024u;
    const int aoff = lds_byte(wr * 64 + fr, fq * 8), boff = lds_byte(wc * 32 + fr, fq * 8);
#define PG8_SA(b, h) (((b) * 2 + (h)) * HTB)
#define PG8_SB(b, h) ((4 + (b) * 2 + (h)) * HTB)
#define PG8_STAGE(bufoff, gbase, voff) do { _Pragma("unroll") for (int _i = 0; _i < 2; ++_i) \
        __builtin_amdgcn_global_load_lds((const unsigned*)((const char*)(gbase) + (voff)[_i]), (PG8_LAS unsigned*)(lds + (bufoff) + ldsw + _i * 8192), 16, 0, 0); } while (0)
#define PG8_LDA(dst, b, h) do { _Pragma("unroll") for (int m = 0; m < 4; ++m) _Pragma("unroll") for (int k = 0; k < 2; ++k) dst[m][k] = *(const PG8_LAS bf16x8*)(lds + PG8_SA(b, h) + aoff + m * 2048 + k * 1024); } while (0)
#define PG8_LDB(dst, b, h) do { _Pragma("unroll") for (int n = 0; n < 2; ++n) _Pragma("unroll") for (int k = 0; k < 2; ++k) dst[n][k] = *(const PG8_LAS bf16x8*)(lds + PG8_SB(b, h) + boff + n * 2048 + k * 1024); } while (0)
#define PG8_MMA(ai, bj, At, Bt) do { __builtin_amdgcn_s_setprio(1); _Pragma("unroll") for (int m = 0; m < 4; ++m) _Pragma("unroll") for (int n = 0; n < 2; ++n) _Pragma("unroll") for (int k = 0; k < 2; ++k) \
        acc[ai][bj][m][n] = __builtin_amdgcn_mfma_f32_16x16x32_bf16(Bt[n][k], At[m][k], acc[ai][bj][m][n], 0, 0, 0); __builtin_amdgcn_s_setprio(0); } while (0)
#define PG8_WAIT_V(n) asm volatile("s_waitcnt vmcnt(" #n ")" ::: "memory")
#define PG8_WAIT_L(n) asm volatile("s_waitcnt lgkmcnt(" #n ")" ::: "memory")
#define PG8_BAR __builtin_amdgcn_s_barrier()
#define PG8_SCHED __builtin_amdgcn_sched_barrier(0)
    Unit cur, nxt; int ui = 0;
    if (!S.next(0, cur)) return;
    f32x4 acc[2][2][4][2];
#pragma unroll
    for (int a = 0; a < 2; ++a)
#pragma unroll
        for (int b = 0; b < 2; ++b)
#pragma unroll
            for (int m = 0; m < 4; ++m)
#pragma unroll
                for (int n = 0; n < 2; ++n) acc[a][b][m][n] = (f32x4){0.f, 0.f, 0.f, 0.f};
    bf16x8 At[4][2], B0[2][2], B1[2][2];
    const char* cA = (const char*)g.A + (size_t)cur.pm * tstep; const char* cB = (const char*)g.Bt + (size_t)cur.pn * tstep;
    S.a_ready(cur);
    if constexpr (SP2) {
        PG8_STAGE(PG8_SB(0, 0), cB, voffB); PG8_STAGE(PG8_SB(0, 1), cB + hstep, voffB); PG8_STAGE(PG8_SA(0, 0), cA, voffA); PG8_STAGE(PG8_SA(0, 1), cA + hstep, voffA);
        if (wr == 1) PG8_BAR;
        PG8_WAIT_V(2); PG8_BAR;
        PG8_STAGE(PG8_SB(1, 0), cB + kstep, voffB); PG8_STAGE(PG8_SA(1, 0), cA + kstep, voffA); PG8_STAGE(PG8_SB(1, 1), cB + hstep + kstep, voffB);
        PG8_WAIT_V(6); PG8_BAR;
    } else {
        PG8_STAGE(PG8_SB(0, 0), cB, voffB); PG8_STAGE(PG8_SA(0, 0), cA, voffA); PG8_STAGE(PG8_SB(0, 1), cB + hstep, voffB); PG8_STAGE(PG8_SA(0, 1), cA + hstep, voffA);
        if (wr == 1) PG8_BAR;
        PG8_WAIT_V(4); PG8_BAR;
        PG8_STAGE(PG8_SB(1, 0), cB + kstep, voffB); PG8_STAGE(PG8_SA(1, 0), cA + kstep, voffA); PG8_STAGE(PG8_SB(1, 1), cB + hstep + kstep, voffB);
        PG8_WAIT_V(6); PG8_BAR;
    }
    for (;;) {
        const bool has_next = S.next(ui + 1, nxt);
        const char* nA = has_next ? (const char*)g.A + (size_t)nxt.pm * tstep : cA; const char* nB = has_next ? (const char*)g.Bt + (size_t)nxt.pn * tstep : cB;
        for (int t = 0; t < nt; t += 2) {
            const bool last = (t == nt - 2);
            const char* a1 = cA + (size_t)(t + 1) * kstep;
            const char* a2 = last ? nA : cA + (size_t)(t + 2) * kstep; const char* b2 = last ? nB : cB + (size_t)(t + 2) * kstep;
            const char* a3 = a2 + kstep; const char* b3 = b2 + kstep;
            if (last && has_next) S.a_ready(nxt);
            if constexpr (SP2) {
            PG8_LDB(B0, 0, 0); PG8_LDB(B1, 0, 1); PG8_SCHED; PG8_LDA(At, 0, 0); PG8_STAGE(PG8_SA(1, 1), a1 + hstep, voffA);
            PG8_WAIT_V(8); PG8_WAIT_L(0); PG8_BAR; PG8_MMA(0, 0, At, B0); PG8_MMA(0, 1, At, B1); PG8_BAR; PG8_SCHED;
            PG8_LDA(At, 0, 1); PG8_STAGE(PG8_SB(0, 0), b2, voffB); PG8_STAGE(PG8_SB(0, 1), b2 + hstep, voffB); PG8_STAGE(PG8_SA(0, 0), a2, voffA);
            PG8_WAIT_V(8); PG8_WAIT_L(0); PG8_BAR; PG8_MMA(1, 0, At, B0); PG8_MMA(1, 1, At, B1); PG8_BAR; PG8_SCHED;
            PG8_LDB(B0, 1, 0); PG8_LDB(B1, 1, 1); PG8_SCHED; PG8_LDA(At, 1, 0); PG8_STAGE(PG8_SA(0, 1), a2 + hstep, voffA);
            PG8_WAIT_V(8); PG8_WAIT_L(0); PG8_BAR; PG8_MMA(0, 0, At, B0); PG8_MMA(0, 1, At, B1); PG8_BAR; PG8_SCHED;
            PG8_LDA(At, 1, 1); PG8_STAGE(PG8_SB(1, 0), b3, voffB); PG8_STAGE(PG8_SB(1, 1), b3 + hstep, voffB); PG8_STAGE(PG8_SA(1, 0), a3, voffA);
            PG8_WAIT_V(8); PG8_WAIT_L(0); PG8_BAR; PG8_MMA(1, 0, At, B0); PG8_MMA(1, 1, At, B1); PG8_BAR; PG8_SCHED;
            } else {
            PG8_LDB(B0, 0, 0); PG8_SCHED; PG8_LDA(At, 0, 0); PG8_STAGE(PG8_SA(1, 1), a1 + hstep, voffA);
            PG8_WAIT_L(8); PG8_BAR; PG8_WAIT_L(0); PG8_MMA(0, 0, At, B0); PG8_BAR; PG8_SCHED;
            PG8_LDB(B1, 0, 1); PG8_STAGE(PG8_SB(0, 0), b2, voffB);
            PG8_BAR; PG8_WAIT_L(0); PG8_MMA(0, 1, At, B1); PG8_BAR;
            PG8_LDA(At, 0, 1); PG8_STAGE(PG8_SA(0, 0), a2, voffA);
            PG8_BAR; PG8_WAIT_L(0); PG8_MMA(1, 0, At, B0); PG8_BAR; PG8_SCHED;
            PG8_STAGE(PG8_SB(0, 1), b2 + hstep, voffB);
            PG8_WAIT_V(6); PG8_BAR; PG8_MMA(1, 1, At, B1); PG8_BAR;
            PG8_LDB(B0, 1, 0); PG8_SCHED; PG8_LDA(At, 1, 0); PG8_STAGE(PG8_SA(0, 1), a2 + hstep, voffA);
            PG8_WAIT_L(8); PG8_BAR; PG8_WAIT_L(0); PG8_MMA(0, 0, At, B0); PG8_BAR; PG8_SCHED;
            PG8_LDB(B1, 1, 1); PG8_STAGE(PG8_SB(1, 0), b3, voffB);
            PG8_BAR; PG8_WAIT_L(0); PG8_MMA(0, 1, At, B1); PG8_BAR;
            PG8_LDA(At, 1, 1); PG8_STAGE(PG8_SA(1, 0), a3, voffA);
            PG8_BAR; PG8_WAIT_L(0); PG8_MMA(1, 0, At, B0); PG8_BAR; PG8_SCHED;
            PG8_STAGE(PG8_SB(1, 1), b3 + hstep, voffB);
            PG8_WAIT_V(6); PG8_BAR; PG8_MMA(1, 1, At, B1); PG8_BAR;
            }
        }
        if constexpr (ALIGN_EPI) { if (wr == 0) PG8_BAR; }
        if constexpr (!Epi::AFTER_DRAIN) { E(acc, cur, wr, wc, fr, fq); S.done(cur); }
        if (!has_next) break;
#pragma unroll
        for (int a = 0; a < 2; ++a)
#pragma unroll
            for (int b = 0; b < 2; ++b)
#pragma unroll
                for (int m = 0; m < 4; ++m)
#pragma unroll
                    for (int n = 0; n < 2; ++n) acc[a][b][m][n] = (f32x4){0.f, 0.f, 0.f, 0.f};
        cur = nxt; cA = nA; cB = nB; ++ui;
        if constexpr (ALIGN_EPI) { if (wr == 1) PG8_BAR; }
    }
    PG8_WAIT_V(0);
    if constexpr (!ALIGN_EPI) { if (wr == 0) PG8_BAR; }
    PG8_BAR;
    if constexpr (Epi::AFTER_DRAIN) { E.fused(acc, cur, wr, wc, fr, fq, lds, wid, lane); S.done(cur); }
#undef PG8_SA
#undef PG8_SB
#undef PG8_STAGE
#undef PG8_LDA
#undef PG8_LDB
#undef PG8_MMA
#undef PG8_WAIT_V
#undef PG8_WAIT_L
#undef PG8_BAR
#undef PG8_SCHED
}
}

#define DEV __device__ __forceinline__
typedef unsigned short bf16_t;
typedef float f32x4 __attribute__((ext_vector_type(4)));
typedef float f32x2 __attribute__((ext_vector_type(2)));
typedef unsigned u32x4 __attribute__((ext_vector_type(4)));
typedef unsigned u32x2 __attribute__((ext_vector_type(2)));
constexpr int MR = 32768, SEQ = 8192, DM = 1024, DFF = 2816, PT = 3792, ZLD = 3840, NB = 4, NH = 4;
constexpr float RMS_EPS = 1e-6f;
constexpr size_t MiB = 1u << 20;
constexpr size_t WS_WGU = 1 * MiB, WS_WD = 23 * MiB, WS_WIN = 34 * MiB, WS_WOUT = 42 * MiB, WS_ROPE = 44 * MiB;
constexpr size_t WS_XB = 46 * MiB, WS_BIG = 110 * MiB, WS_SCR = 350 * MiB;
constexpr size_t WS_D = WS_SCR;
constexpr size_t WS_RET = WS_SCR, WS_MLC = WS_SCR + 32 * MiB, WS_MLN = WS_SCR + 64 * MiB, WS_MLS = WS_SCR + 64 * MiB + 512 * 1024;
constexpr size_t WS_PE = WS_SCR + 65 * MiB, WS_WKV = WS_SCR + 97 * MiB, WS_SBON = WS_SCR + 161 * MiB, WS_END = 512 * MiB;
constexpr int LDS_BYTES = 163840;
constexpr int RW_LC = 256, RW_NC = SEQ / RW_LC, RW_T = 8;
constexpr int CH = 128, NCH = SEQ / CH;

struct Params { const float* in[24]; float* out; unsigned char* ws; };
typedef const __attribute__((address_space(4))) Params* PP;
DEV PP fresh_params() { PP q = (PP)__builtin_amdgcn_kernarg_segment_ptr(); asm volatile("" : "+s"(q)); return q; }
DEV int otid() { int t = threadIdx.x; asm volatile("" : "+v"(t)); return t; }

DEV float bf2f(bf16_t v) { return __uint_as_float(((unsigned)v) << 16); }
DEV unsigned f2bf(float f) { unsigned u = __float_as_uint(f); return (u + 0x7fffu + ((u >> 16) & 1u)) >> 16; }
DEV unsigned pk2(float lo, float hi) { return f2bf(lo) | (f2bf(hi) << 16); }
template <int CTRL> DEV float dppf(float v) { return __int_as_float(__builtin_amdgcn_update_dpp(0, __float_as_int(v), CTRL, 0xf, 0xf, true)); }
DEV float wave_sum(float v) {
    v += dppf<0xB1>(v); v += dppf<0x4E>(v); v += dppf<0x141>(v); v += dppf<0x140>(v);
    const int vi = __float_as_int(v);
    return (__int_as_float(__builtin_amdgcn_readlane(vi, 0)) + __int_as_float(__builtin_amdgcn_readlane(vi, 16))) + (__int_as_float(__builtin_amdgcn_readlane(vi, 32)) + __int_as_float(__builtin_amdgcn_readlane(vi, 48)));
}
DEV float sigmoid_f(float x) { return 1.0f / (1.0f + __expf(-x)); }
DEV float softplus_f(float x) { return fmaxf(x, 0.f) + __logf(1.0f + __expf(-fabsf(x))); }
DEV float tanh_f(float x) { return 1.0f - 2.0f * __builtin_amdgcn_rcpf(1.0f + __expf(2.0f * x)); }
DEV void unpack8(const u32x4 w, float* f) {
    f[0] = __uint_as_float(w.x << 16); f[1] = __uint_as_float(w.x & 0xffff0000u); f[2] = __uint_as_float(w.y << 16); f[3] = __uint_as_float(w.y & 0xffff0000u);
    f[4] = __uint_as_float(w.z << 16); f[5] = __uint_as_float(w.z & 0xffff0000u); f[6] = __uint_as_float(w.w << 16); f[7] = __uint_as_float(w.w & 0xffff0000u);
}

DEV void conv_tile(const float* W, int K, int N, bf16_t* WT, int mode, int tile, float* scr) {
    const int nkt = K >> 6; const int kt = tile % nkt, nt = tile / nkt, k0 = kt * 64, n0 = nt * 64, tid = otid();
#pragma unroll
    for (int e = 0; e < 8; ++e) { const int idx = e * 512 + tid, kk = idx >> 6, nn = idx & 63;
        const float v = (n0 + nn < N) ? W[(size_t)(k0 + kk) * N + n0 + nn] : 0.f; scr[nn * 65 + kk] = v; }
    __syncthreads();
    { const int nn = tid >> 3, c8 = tid & 7; const float* s = scr + nn * 65 + c8 * 8; const int n = n0 + nn;
      const int drow = mode == 0 ? n : ((n >> 7) * 256 + (n & 127) + (mode == 2 ? 128 : 0));
      u32x4 o; o.x = pk2(s[0], s[1]); o.y = pk2(s[2], s[3]); o.z = pk2(s[4], s[5]); o.w = pk2(s[6], s[7]);
      *(u32x4*)(WT + (size_t)drow * K + k0 + c8 * 8) = o; }
    __syncthreads();
}
DEV void convert_weights(PP p, int l, float* scr) {
    unsigned char* ws = p->ws;
    const int T_GU = 16 * 44, T_D = 44 * 16, T_IN = 16 * 60, T_OUT = 16 * 16;
    const int total = 4 * T_GU + 2 * T_D + T_IN + T_OUT;
    for (int it = blockIdx.x; it < total; it += gridDim.x) {
        int r = it;
        if (r < 4 * T_GU) { const int f = r / (2 * T_GU), which = (r / T_GU) & 1, t = r % T_GU;
            const float* W = p->in[which ? 3 : 2] + (size_t)(l * 2 + f) * DM * DFF;
            conv_tile(W, DM, DFF, (bf16_t*)(ws + WS_WGU + (size_t)f * 11 * MiB), which ? 2 : 1, t, scr); continue; }
        r -= 4 * T_GU;
        if (r < 2 * T_D) { const int f = r / T_D, t = r % T_D;
            conv_tile(p->in[4] + (size_t)(l * 2 + f) * DFF * DM, DFF, DM, (bf16_t*)(ws + WS_WD + (size_t)f * (11 * MiB / 2)), 0, t, scr); continue; }
        r -= 2 * T_D;
        if (r < T_IN) { conv_tile(p->in[5] + (size_t)l * DM * PT, DM, PT, (bf16_t*)(ws + WS_WIN), 0, r, scr); continue; }
        r -= T_IN;
        conv_tile(p->in[6] + (size_t)l * DM * DM, DM, DM, (bf16_t*)(ws + WS_WOUT), 0, r, scr);
    }
}
DEV void row_phase(const float* xin, float* xout, const bf16_t* d, const float* gA, float coef, const float* gB, bf16_t* xb) {
    const int tid_ = otid(); const int lane = tid_ & 63, gw = blockIdx.x * 8 + (tid_ >> 6), ngw = gridDim.x * 8;
    for (int row = gw; row < MR; row += ngw) {
        f32x4 v[4];
#pragma unroll
        for (int j = 0; j < 4; ++j) v[j] = ((const f32x4*)(xin + (size_t)row * DM))[lane + 64 * j];
        if (d) {
            f32x4 dv[4]; float ss = 0.f;
#pragma unroll
            for (int j = 0; j < 4; ++j) { const u32x2 w = ((const u32x2*)(d + (size_t)row * DM))[lane + 64 * j];
                dv[j][0] = __uint_as_float(w.x << 16); dv[j][1] = __uint_as_float(w.x & 0xffff0000u); dv[j][2] = __uint_as_float(w.y << 16); dv[j][3] = __uint_as_float(w.y & 0xffff0000u);
                ss += dv[j][0] * dv[j][0] + dv[j][1] * dv[j][1] + dv[j][2] * dv[j][2] + dv[j][3] * dv[j][3]; }
            const float rs = coef * rsqrtf(wave_sum(ss) * (1.f / DM) + RMS_EPS);
#pragma unroll
            for (int j = 0; j < 4; ++j) { const f32x4 g = ((const f32x4*)gA)[lane + 64 * j]; v[j] += dv[j] * g * rs; }
        }
#pragma unroll
        for (int j = 0; j < 4; ++j) ((f32x4*)(xout + (size_t)row * DM))[lane + 64 * j] = v[j];
        if (xb) {
            float ss = 0.f;
#pragma unroll
            for (int j = 0; j < 4; ++j) ss += v[j][0] * v[j][0] + v[j][1] * v[j][1] + v[j][2] * v[j][2] + v[j][3] * v[j][3];
            const float rs = rsqrtf(wave_sum(ss) * (1.f / DM) + RMS_EPS);
#pragma unroll
            for (int j = 0; j < 4; ++j) { const f32x4 g = ((const f32x4*)gB)[lane + 64 * j]; const f32x4 o = v[j] * g * rs;
                u32x2 w; w.x = pk2(o[0], o[1]); w.y = pk2(o[2], o[3]); ((u32x2*)(xb + (size_t)row * DM))[lane + 64 * j] = w; }
        }
    }
}
DEV f32x4 mm16(const float* A, int ars, int aks, const float* B, int bks, int bjs, int k_lo, int k_hi, f32x4 acc, int lane) {
    const int i = lane & 15, kq = lane >> 4;
    const float* ap = A + i * ars + kq * aks; const float* bp = B + kq * bks + i * bjs;
    for (int k0 = k_lo; k0 < k_hi; k0 += 4) acc = __builtin_amdgcn_mfma_f32_16x16x4f32(ap[k0 * aks], bp[k0 * bks], acc, 0, 0, 0);
    return acc;
}

constexpr int L_Q = 0, L_K = L_Q + 128 * 68, L_V = L_K + 128 * 68, L_S = L_V + 128 * 72, L_ST = L_S + 64 * 132, L_VEC = L_ST + 64 * 72, L_END = L_VEC + 9 * 128 + 64;
static_assert(L_END * 4 <= LDS_BYTES, "lds");
struct MixCtx { const bf16_t* z; const float* rope; float lg0, lg1, ib0, ib1, fb0, fb1; int mode; int b, h, c; };

DEV void mix_load_qkv(const MixCtx& m, float* lds, bool need_q) {
    const int tid = otid(), tok = tid >> 2, oct = tid & 3, t = m.c * CH + tok; const size_t row = (size_t)m.b * SEQ + t;
    const bf16_t* zr = m.z + row * ZLD + (m.mode == 0 ? 768 : 2752) + m.h * 64;
    float q1[8], q2[8], k1[8], k2[8], v1[8], v2[8];
    unpack8(*(const u32x4*)(zr + 256 + oct * 8), k1); unpack8(*(const u32x4*)(zr + 256 + 32 + oct * 8), k2);
    unpack8(*(const u32x4*)(zr + 512 + oct * 8), v1); unpack8(*(const u32x4*)(zr + 512 + 32 + oct * 8), v2);
    if (need_q) { unpack8(*(const u32x4*)(zr + oct * 8), q1); unpack8(*(const u32x4*)(zr + 32 + oct * 8), q2); }
    float* qs = lds + L_Q + tok * 68; float* ks = lds + L_K + tok * 68; float* vs = lds + L_V + tok * 72;
    if (m.mode == 0) {
        const float* cs = m.rope + (size_t)t * 32 + oct * 8; const float* sn = cs + SEQ * 32;
#pragma unroll
        for (int e = 0; e < 8; ++e) { const float c = cs[e], s = sn[e];
            const float ka = k1[e] * c - k2[e] * s, kb = k1[e] * s + k2[e] * c; ks[oct * 8 + e] = ka; ks[32 + oct * 8 + e] = kb;
            if (need_q) { const float qa = (q1[e] * c - q2[e] * s) * 0.125f, qb = (q1[e] * s + q2[e] * c) * 0.125f; qs[oct * 8 + e] = qa; qs[32 + oct * 8 + e] = qb; } }
    } else {
#pragma unroll
        for (int e = 0; e < 8; ++e) { ks[oct * 8 + e] = k1[e]; ks[32 + oct * 8 + e] = k2[e];
            if (need_q) { qs[oct * 8 + e] = q1[e] * 0.125f; qs[32 + oct * 8 + e] = q2[e] * 0.125f; } }
    }
#pragma unroll
    for (int e = 0; e < 8; ++e) { vs[oct * 8 + e] = v1[e]; vs[32 + oct * 8 + e] = v2[e]; }
}
DEV void mix_vectors(const MixCtx& m, float* lds, int d, float m_prev) {
    float* V = lds + L_VEC; const int tid = otid();
    if (m.mode == 0) {
        if (tid < 128) { const float lg = d == 0 ? m.lg0 : m.lg1;
            V[0 * 128 + tid] = d == 0 ? __expf((tid + 1) * lg) : __expf((128 - tid) * lg);
            V[1 * 128 + tid] = d == 0 ? __expf((127 - tid) * lg) : __expf(tid * lg); }
        __syncthreads();
        return;
    }
    if (tid < 128) { const size_t row = (size_t)m.b * SEQ + m.c * CH + tid; const bf16_t* zr = m.z + row * ZLD;
        const float li = bf2f(zr[3776 + d * 4 + m.h]) + (d == 0 ? m.ib0 : m.ib1); const float xf = bf2f(zr[3784 + d * 4 + m.h]) + (d == 0 ? m.fb0 : m.fb1);
        V[6 * 128 + tid] = li; V[7 * 128 + tid] = fminf(xf, 0.f) - log1pf(__expf(-fabsf(xf))); }
    __syncthreads();
    if (tid < 64) {
        const int s0 = d == 0 ? 2 * tid : 127 - 2 * tid, s1 = d == 0 ? 2 * tid + 1 : 126 - 2 * tid;
        const float lf0 = V[7 * 128 + s0], lf1 = V[7 * 128 + s1]; const float pair = lf0 + lf1; float incl = pair;
#pragma unroll
        for (int off = 1; off < 64; off <<= 1) { const float t = __shfl_up(incl, off); if (tid >= off) incl += t; }
        const float b0 = incl - pair + lf0, b1 = b0 + lf1;
        const float g0 = V[6 * 128 + s0] - b0, g1 = V[6 * 128 + s1] - b1;
        float inclm = fmaxf(g0, g1);
#pragma unroll
        for (int off = 1; off < 64; off <<= 1) { const float t = __shfl_up(inclm, off); if (tid >= off) inclm = fmaxf(inclm, t); }
        float exclm = __shfl_up(inclm, 1); if (tid == 0) exclm = -3.0e38f;
        const float gm0 = fmaxf(exclm, g0), gm1 = fmaxf(gm0, g1);
        V[7 * 128 + s0] = b0; V[7 * 128 + s1] = b1; V[2 * 128 + s0] = g0; V[2 * 128 + s1] = g1; V[3 * 128 + s0] = gm0; V[3 * 128 + s1] = gm1;
        if (tid == 63) { V[8 * 128 + 0] = b1; V[8 * 128 + 1] = gm1; }
    }
    __syncthreads();
    if (tid < 128) { const float gmax_t = V[3 * 128 + tid], Mt = fmaxf(m_prev, gmax_t), bt = V[7 * 128 + tid];
        const float gend = V[8 * 128 + 1];
        V[0 * 128 + tid] = __expf(m_prev - Mt); V[4 * 128 + tid] = __expf(-(bt + Mt)); V[1 * 128 + tid] = __expf(V[2 * 128 + tid] - gend);
        V[3 * 128 + tid] = Mt; }
    __syncthreads();
}
DEV void mix_passA(const MixCtx& m, float* lds, float* states, float* nst, float* sst) {
    const int tid = otid(), lane = tid & 63, wave = __builtin_amdgcn_readfirstlane(tid >> 6);
    mix_load_qkv(m, lds, false);
    __syncthreads();
    for (int d = 0; d < 2; ++d) {
        mix_vectors(m, lds, d, 0.f);
        const float* wst = lds + L_VEC + 128; const float* ks = lds + L_K; const float* vs = lds + L_V;
        const size_t slot = ((size_t)((m.b * NH + m.h) * 2 + d)) * NCH + m.c;
        float* st = states + slot * 4096;
#pragma unroll
        for (int q = 0; q < 2; ++q) { const int id = wave + 8 * q, rt = id >> 2, ct = id & 3; const int i = lane & 15, kq = lane >> 4;
            f32x4 acc = {0.f, 0.f, 0.f, 0.f};
            for (int k0 = 0; k0 < 128; k0 += 4) { const int s = k0 + kq; acc = __builtin_amdgcn_mfma_f32_16x16x4f32(ks[s * 68 + 16 * rt + i] * wst[s], vs[s * 72 + 16 * ct + i], acc, 0, 0, 0); }
#pragma unroll
            for (int r = 0; r < 4; ++r) st[(16 * rt + kq * 4 + r) * 64 + 16 * ct + i] = acc[r]; }
        if (m.mode == 1) {
            if (tid < 64) { float a = 0.f; for (int s = 0; s < 128; ++s) a += wst[s] * ks[s * 68 + tid]; nst[slot * 64 + tid] = a; }
            if (tid == 64) { const float* V = lds + L_VEC; sst[slot] = V[8 * 128 + 0]; sst[4096 + slot] = V[8 * 128 + 0] + V[8 * 128 + 1]; }
        }
        __syncthreads();
    }
}
DEV void mix_passC(const MixCtx& m, float* lds, const float* states, const float* nst, const float* sst, bf16_t* Y, const float* norm_w) {
    const int tid = otid(), lane = tid & 63, wave = __builtin_amdgcn_readfirstlane(tid >> 6), i16 = lane & 15, kq = lane >> 4;
    f32x4 oacc[4];
#pragma unroll
    for (int a = 0; a < 4; ++a) oacc[a] = (f32x4){0.f, 0.f, 0.f, 0.f};
    mix_load_qkv(m, lds, true);
    __syncthreads();
    float* V = lds + L_VEC; float* qs = lds + L_Q; float* ks = lds + L_K; float* vs = lds + L_V; float* Sh = lds + L_S; float* St = lds + L_ST;
    for (int d = 0; d < 2; ++d) {
        const size_t slot = ((size_t)((m.b * NH + m.h) * 2 + d)) * NCH + m.c;
        const float m_prev = m.mode == 1 ? sst[8192 + slot] : 0.f;
        { const float* st = states + slot * 4096;
#pragma unroll
          for (int e = 0; e < 8; ++e) { const int idx = e * 512 + tid; St[(idx >> 6) * 72 + (idx & 63)] = st[idx]; }
          if (m.mode == 1 && tid < 64) V[9 * 128 + tid] = nst[slot * 64 + tid]; }
        mix_vectors(m, lds, d, m_prev);
        const float lg = d == 0 ? m.lg0 : m.lg1;
        for (int hf = 0; hf < 2; ++hf) {
#pragma unroll
            for (int q = 0; q < 4; ++q) { const int id = wave + 8 * q, rt = id >> 3, ct = id & 7; const int tr = 64 * hf + 16 * rt, sc = 16 * ct;
                const bool masked = d == 0 ? (sc > tr + 15) : (sc + 15 < tr);
                f32x4 acc = {0.f, 0.f, 0.f, 0.f};
                if (!masked) {
                    acc = mm16(qs + tr * 68, 68, 1, ks + sc * 68, 1, 68, 0, 64, acc, lane);
                    const int s = sc + i16;
#pragma unroll
                    for (int r = 0; r < 4; ++r) { const int t = tr + kq * 4 + r; float w;
                        if (m.mode == 0) { w = d == 0 ? (s <= t ? __expf((float)(t - s) * lg) : 0.f) : (s > t ? __expf((float)(s - t) * lg) : 0.f); }
                        else { const bool ok = d == 0 ? (s <= t) : (s >= t); w = ok ? __expf(V[2 * 128 + s] - V[3 * 128 + t]) : 0.f; }
                        acc[r] *= w; } }
#pragma unroll
                for (int r = 0; r < 4; ++r) Sh[(16 * rt + kq * 4 + r) * 132 + sc + i16] = acc[r]; }
            __syncthreads();
            if (m.mode == 1) { const int row = tid >> 3, seg = tid & 7, t = 64 * hf + row; float a = 0.f;
#pragma unroll
                for (int e = 0; e < 16; ++e) a += Sh[row * 132 + seg * 16 + e];
                float qn = 0.f;
#pragma unroll
                for (int e = 0; e < 8; ++e) qn += qs[t * 68 + seg * 8 + e] * V[9 * 128 + seg * 8 + e];
                a += V[0 * 128 + t] * qn;
                a += __shfl_xor(a, 1); a += __shfl_xor(a, 2); a += __shfl_xor(a, 4);
                if (seg == 0) V[5 * 128 + t] = a;
                __syncthreads(); }
#pragma unroll
            for (int q = 0; q < 2; ++q) { const int id = wave + 8 * q, rt = id >> 2, ct = id & 3; const int tr = 64 * hf + 16 * rt;
                const int k_lo = d == 0 ? 0 : tr, k_hi = d == 0 ? tr + 16 : 128;
                f32x4 intra = {0.f, 0.f, 0.f, 0.f}, inter = {0.f, 0.f, 0.f, 0.f};
                intra = mm16(Sh + 16 * rt * 132, 132, 1, vs + 16 * ct, 72, 1, k_lo, k_hi, intra, lane);
                inter = mm16(qs + tr * 68, 68, 1, St + 16 * ct, 72, 1, 0, 64, inter, lane);
#pragma unroll
                for (int r = 0; r < 4; ++r) { const int t = tr + kq * 4 + r; float val = intra[r] + V[0 * 128 + t] * inter[r];
                    if (m.mode == 1) val = val / fmaxf(fabsf(V[5 * 128 + t]), V[4 * 128 + t]);
                    oacc[hf * 2 + q][r] += val; } }
            __syncthreads();
        }
    }
    float* os = lds + L_S;
#pragma unroll
    for (int hf = 0; hf < 2; ++hf)
#pragma unroll
        for (int q = 0; q < 2; ++q) { const int id = wave + 8 * q, rt = id >> 2, ct = id & 3; const int tr = 64 * hf + 16 * rt;
#pragma unroll
            for (int r = 0; r < 4; ++r) os[(tr + kq * 4 + r) * 66 + 16 * ct + i16] = oacc[hf * 2 + q][r]; }
    __syncthreads();
    { const int tok = tid >> 2, qd = tid & 3; const size_t row = (size_t)m.b * SEQ + m.c * CH + tok; float o[16]; float ss = 0.f;
#pragma unroll
      for (int e = 0; e < 16; ++e) { o[e] = os[tok * 66 + qd * 16 + e]; ss += o[e] * o[e]; }
      ss += __shfl_xor(ss, 1); ss += __shfl_xor(ss, 2);
      const float rs = rsqrtf(ss * (1.f / 64.f) + RMS_EPS);
      const bf16_t* zg = m.z + row * ZLD + (m.mode == 0 ? 1536 : 3520) + m.h * 64 + qd * 16;
      float g[16]; unpack8(*(const u32x4*)zg, g); unpack8(*(const u32x4*)(zg + 8), g + 8);
      float y[16];
#pragma unroll
      for (int e = 0; e < 16; ++e) { const float gate = m.mode == 0 ? g[e] * sigmoid_f(g[e]) : sigmoid_f(g[e]) * norm_w[m.h * 64 + qd * 16 + e]; y[e] = o[e] * rs * gate; }
      u32x4 w0, w1; w0.x = pk2(y[0], y[1]); w0.y = pk2(y[2], y[3]); w0.z = pk2(y[4], y[5]); w0.w = pk2(y[6], y[7]);
      w1.x = pk2(y[8], y[9]); w1.y = pk2(y[10], y[11]); w1.z = pk2(y[12], y[13]); w1.w = pk2(y[14], y[15]);
      bf16_t* yp = Y + row * DM + (m.mode == 0 ? 256 : 768) + m.h * 64 + qd * 16;
      *(u32x4*)yp = w0; *(u32x4*)(yp + 8) = w1; }
    __syncthreads();
}

DEV void mix_passB(PP p, int l, float* lds) {
    float* rs = (float*)(p->ws + WS_RET); float* mc = (float*)(p->ws + WS_MLC); float* mn = (float*)(p->ws + WS_MLN); float* ms = (float*)(p->ws + WS_MLS);
    const float* dl = p->in[9] + l * 8; const int tid = otid();
    const int G = gridDim.x; const int first = G > 64 ? 32 : 0, nW = G - first, w = (int)blockIdx.x - first;
    if (w < 0) return;
    float* so_l = lds; float* sn_l = lds + 64;
    for (int item = w; item < 256; item += nW) {
        const int seq = item >> 3, el = ((item & 7) << 9) + tid, d = seq & 1, h = (seq >> 1) & 3;
        __syncthreads();
        if (tid == 0) { float mm = 0.f;
            for (int i = 0; i < NCH; ++i) { const int c = d ? NCH - 1 - i : i; const int slot = seq * NCH + c; const float bend = ms[slot], mloc = ms[4096 + slot];
                const float mnew = fmaxf(bend + mm, mloc); so_l[c] = __expf(bend + mm - mnew); sn_l[c] = __expf(mloc - mnew); if ((item & 7) == 0) ms[8192 + slot] = mm; mm = mnew; } }
        {
            const float x = dl[d * 4 + h]; const float lg = fminf(x, 0.f) - log1pf(__expf(-fabsf(x))); const float dec = __expf(128.f * lg);
            float* base = rs + (size_t)seq * NCH * 4096 + el; float F = 0.f;
#pragma unroll 1
            for (int bt = 0; bt < 4; ++bt) { float v[16]; float* bb = base + (size_t)(d ? 3 - bt : bt) * 16 * 4096;
#pragma unroll
                for (int i = 0; i < 16; ++i) v[i] = bb[(size_t)i * 4096];
                if (d == 0) {
#pragma unroll
                    for (int i = 0; i < 16; ++i) { const float t = v[i]; v[i] = F; F = dec * F + t; }
                } else {
#pragma unroll
                    for (int i = 15; i >= 0; --i) { const float t = v[i]; v[i] = F; F = dec * F + t; }
                }
#pragma unroll
                for (int i = 0; i < 16; ++i) bb[(size_t)i * 4096] = v[i]; }
        }
        __syncthreads();
        {
            float* base = mc + (size_t)seq * NCH * 4096 + el; float C = 0.f;
#pragma unroll 1
            for (int bt = 0; bt < 4; ++bt) { float v[16]; const int c0 = (d ? 3 - bt : bt) * 16; float* bb = base + (size_t)c0 * 4096;
#pragma unroll
                for (int i = 0; i < 16; ++i) v[i] = bb[(size_t)i * 4096];
                if (d == 0) {
#pragma unroll
                    for (int i = 0; i < 16; ++i) { const float t = v[i]; v[i] = C; C = so_l[c0 + i] * C + sn_l[c0 + i] * t; }
                } else {
#pragma unroll
                    for (int i = 15; i >= 0; --i) { const float t = v[i]; v[i] = C; C = so_l[c0 + i] * C + sn_l[c0 + i] * t; }
                }
#pragma unroll
                for (int i = 0; i < 16; ++i) bb[(size_t)i * 4096] = v[i]; }
        }
        if ((item & 7) == 0 && tid < 64) {
            float* nb = mn + (size_t)seq * NCH * 64 + tid; float nn = 0.f;
            for (int i = 0; i < NCH; ++i) { const int c = d ? NCH - 1 - i : i; const float nl = nb[(size_t)c * 64]; nb[(size_t)c * 64] = nn; nn = so_l[c] * nn + sn_l[c] * nl; }
        }
    }
}
DEV void conv_mixer(PP p, int l, const bf16_t* z, bf16_t* Y) {
    const float* cw = p->in[7] + l * 768; const float* cb = p->in[8] + l * 256;
    const int gt = blockIdx.x * 512 + otid(), ngt = gridDim.x * 512;
    for (int it = gt; it < MR * 32; it += ngt) {
        const int row = it >> 5, c8 = (it & 31) * 8, t = row & (SEQ - 1); const bf16_t* zr = z + (size_t)row * ZLD;
        float gb[8], a[8], b[8], up[8], un[8], u[8];
        unpack8(*(const u32x4*)(zr + c8), gb); unpack8(*(const u32x4*)(zr + 256 + c8), a); unpack8(*(const u32x4*)(zr + 512 + c8), b);
#pragma unroll
        for (int e = 0; e < 8; ++e) { u[e] = a[e] * b[e]; up[e] = 0.f; un[e] = 0.f; }
        if (t > 0) { unpack8(*(const u32x4*)(zr - ZLD + 256 + c8), a); unpack8(*(const u32x4*)(zr - ZLD + 512 + c8), b);
#pragma unroll
            for (int e = 0; e < 8; ++e) up[e] = a[e] * b[e]; }
        if (t < SEQ - 1) { unpack8(*(const u32x4*)(zr + ZLD + 256 + c8), a); unpack8(*(const u32x4*)(zr + ZLD + 512 + c8), b);
#pragma unroll
            for (int e = 0; e < 8; ++e) un[e] = a[e] * b[e]; }
        float y[8];
#pragma unroll
        for (int e = 0; e < 8; ++e) y[e] = gb[e] * (up[e] * cw[c8 + e] + u[e] * cw[256 + c8 + e] + un[e] * cw[512 + c8 + e] + cb[c8 + e]);
        u32x4 w; w.x = pk2(y[0], y[1]); w.y = pk2(y[2], y[3]); w.z = pk2(y[4], y[5]); w.w = pk2(y[6], y[7]);
        *(u32x4*)(Y + (size_t)row * DM + c8) = w;
    }
}

DEV float rw_shift(const bf16_t* z, size_t row, int t, int col, const float* mu) {
    const bf16_t* zr = z + row * ZLD + 1792 + col; const float x = bf2f(zr[0]);
    const float pv = t > 0 ? bf2f(zr[-ZLD]) : 0.f, nx = t < SEQ - 1 ? bf2f(zr[ZLD]) : 0.f;
    return x + mu[col] * (0.5f * (pv + nx) - x);
}
struct RwCtx { const bf16_t* z; const float *mu, *w0, *w2, *a0, *a2, *k_k, *k_a, *r_k; float* sbon; int b, c, d; };
DEV void rw_load_raw(const RwCtx& R, int sb, int ch, int lc, float (&raw)[40]) {
    const int sgn = R.d == 0 ? 1 : -1; const int first = R.c * RW_LC + (R.d == 0 ? sb * RW_T : RW_LC - 1 - sb * RW_T);
#pragma unroll
    for (int q = 0; q < 10; ++q) { const int t = first + sgn * (q - 1); const bool ok = (t >= 0) && (t < SEQ);
        const bf16_t* zr = R.z + ((size_t)R.b * SEQ + (ok ? t : 0)) * ZLD + 1792;
        raw[q * 4 + 0] = ok ? bf2f(zr[ch]) : 0.f; raw[q * 4 + 1] = ok ? bf2f(zr[256 + ch]) : 0.f; raw[q * 4 + 2] = ok ? bf2f(zr[512 + ch]) : 0.f; raw[q * 4 + 3] = ok ? bf2f(zr[lc]) : 0.f; }
}
struct RwConst { float mur, muk, muv, mul, w0v, a0v, kkw, kaw, rkw; };
template <int PASS> DEV void rw_prep(const RwCtx& R, const RwConst& K, float* ops, float* latw, int sb, int bi, int hp, int lane, const float (&w2r)[32], const float (&a2r)[32], const float (&raw)[40]) {
    const int d = R.d;
    float* obase = ops + ((bi * 4 + hp) * RW_T) * 384;
    float kx[RW_T], rx[RW_T];
#pragma unroll
    for (int j = 0; j < RW_T; ++j) {
        const float* c = raw + (j + 1) * 4; const float* pv = raw + j * 4; const float* nx = raw + (j + 2) * 4;
        rx[j] = c[0] + K.mur * (0.5f * (pv[0] + nx[0]) - c[0]); kx[j] = c[1] + K.muk * (0.5f * (pv[1] + nx[1]) - c[1]);
        const float vv = c[2] + K.muv * (0.5f * (pv[2] + nx[2]) - c[2]); float lv = c[3] + K.mul * (0.5f * (pv[3] + nx[3]) - c[3]);
        if (lane < 32) lv = tanh_f(lv);
        float* o = obase + j * 384;
        latw[j * 64 + lane] = lv; o[256 + lane] = rx[j]; o[320 + lane] = vv; }
    asm volatile("s_waitcnt lgkmcnt(0)" ::: "memory");
#pragma unroll
    for (int j = 0; j < RW_T; ++j) {
        float accw = 0.f, acca = 0.f;
#pragma unroll
        for (int r4 = 0; r4 < 8; ++r4) { const f32x4 lw = *(const f32x4*)(latw + j * 64 + 4 * r4), la = *(const f32x4*)(latw + j * 64 + 32 + 4 * r4);
            accw += lw[0] * w2r[4 * r4] + lw[1] * w2r[4 * r4 + 1] + lw[2] * w2r[4 * r4 + 2] + lw[3] * w2r[4 * r4 + 3];
            acca += la[0] * a2r[4 * r4] + la[1] * a2r[4 * r4 + 1] + la[2] * a2r[4 * r4 + 2] + la[3] * a2r[4 * r4 + 3]; }
        float* o = obase + j * 384;
        const float wlog = -softplus_f(-(K.w0v + accw)) - 0.5f; const float decay = __expf(-__expf(wlog));
        const float a = sigmoid_f(K.a0v + acca);
        const float kkv = kx[j] * K.kkw; const float ss = wave_sum(kkv * kkv); const float kkn = kkv / fmaxf(sqrtf(ss), 1e-12f);
        const float kd = kx[j] * (1.f + (a - 1.f) * K.kaw);
        o[lane] = decay; o[64 + lane] = kkn * a; o[128 + lane] = kd; o[192 + lane] = -kkn;
        if (PASS == 2) { const float sbv = wave_sum(rx[j] * kd * K.rkw);
            const int jj = d == 0 ? sb * RW_T + j : RW_LC - 1 - (sb * RW_T + j); const size_t row = (size_t)R.b * SEQ + R.c * RW_LC + jj;
            if (lane == 0) R.sbon[((size_t)d * MR + row) * 4 + hp] = sbv; }
    }
}
template <int PASS> DEV void rw_task(PP p, int l, int task, float* lds) {
    const int tid = otid(), wave = __builtin_amdgcn_readfirstlane(tid >> 6), lane = tid & 63;
    RwCtx R; R.z = (const bf16_t*)(p->ws + WS_BIG); R.mu = p->in[10] + l * 960; R.w0 = p->in[11] + l * 512; R.w2 = p->in[12] + l * 16384; R.a0 = p->in[13] + l * 512; R.a2 = p->in[14] + l * 16384;
    R.k_k = p->in[16] + l * 256; R.k_a = p->in[17] + l * 256; R.r_k = p->in[18] + l * 256; R.sbon = (float*)(p->ws + WS_SBON);
    R.d = task & 1; R.c = (task >> 1) & (RW_NC - 1); R.b = task >> 6;
    float* ops = lds; float* latw = lds + 2 * 4 * RW_T * 384 + (wave & 3) * RW_T * 64;
    float* pe = (float*)(p->ws + WS_PE); float* wkv = (float*)(p->ws + WS_WKV);
    const int h = wave & 3; const int chain = (R.b * NH + h) * 2 + R.d; const int sc = R.d == 0 ? R.c : RW_NC - 1 - R.c;
    float* slot = pe + ((size_t)chain * RW_NC + sc) * 8192;
    if (wave >= 4) {
        const int hp = wave - 4, ch = hp * 64 + lane; const int lc = lane < 32 ? 768 + R.d * 32 + lane : 832 + R.d * 32 + (lane - 32);
        float w2r[32], a2r[32];
#pragma unroll
        for (int r = 0; r < 32; ++r) { w2r[r] = R.w2[(R.d * 32 + r) * 256 + ch]; a2r[r] = R.a2[(R.d * 32 + r) * 256 + ch]; }
        RwConst K; K.mur = R.mu[ch]; K.muk = R.mu[256 + ch]; K.muv = R.mu[512 + ch]; K.mul = R.mu[lc];
        K.w0v = R.w0[R.d * 256 + ch]; K.a0v = R.a0[R.d * 256 + ch]; K.kkw = R.k_k[ch]; K.kaw = R.k_a[ch]; K.rkw = R.r_k[ch];
        float raw[40], nxt[40];
        rw_load_raw(R, 0, ch, lc, raw);
        rw_load_raw(R, 1, ch, lc, nxt);
        rw_prep<PASS>(R, K, ops, latw, 0, 0, hp, lane, w2r, a2r, raw);
        __syncthreads();
#pragma unroll 1
        for (int sb = 0; sb < RW_LC / RW_T; ++sb) {
            if (sb + 1 < RW_LC / RW_T) {
#pragma unroll
                for (int e = 0; e < 40; ++e) raw[e] = nxt[e];
                if (sb + 2 < RW_LC / RW_T) rw_load_raw(R, sb + 2, ch, lc, nxt);
                rw_prep<PASS>(R, K, ops, latw, sb + 1, (sb + 1) & 1, hp, lane, w2r, a2r, raw); }
            __syncthreads();
        }
        return;
    }
    f32x2 S[32], P[32];
    if (PASS == 1) {
#pragma unroll
        for (int k = 0; k < 32; ++k) { S[k] = (f32x2){0.f, 0.f}; P[k] = (f32x2){(2 * k == lane) ? 1.f : 0.f, (2 * k + 1 == lane) ? 1.f : 0.f}; }
    } else {
#pragma unroll
        for (int k = 0; k < 16; ++k) { const f32x4 v = *(const f32x4*)(slot + 4096 + lane * 64 + 4 * k); S[2 * k] = (f32x2){v[0], v[1]}; S[2 * k + 1] = (f32x2){v[2], v[3]};
            P[2 * k] = (f32x2){0.f, 0.f}; P[2 * k + 1] = (f32x2){0.f, 0.f}; }
    }
    __syncthreads();
#pragma unroll 1
    for (int sb = 0; sb < RW_LC / RW_T; ++sb) {
#pragma unroll 1
        for (int j = 0; j < RW_T; ++j) {
            const float* o = ops + (((sb & 1) * 4 + h) * RW_T + j) * 384;
            const float vv = o[320 + lane];
            f32x2 sa2 = {0.f, 0.f}, sp2 = {0.f, 0.f};
#pragma unroll
            for (int k = 0; k < 16; ++k) { const f32x4 nk = *(const f32x4*)(o + 192 + 4 * k); const f32x2 n0 = {nk[0], nk[1]}, n1 = {nk[2], nk[3]};
                sa2 += S[2 * k] * n0; sa2 += S[2 * k + 1] * n1;
                if (PASS == 1) { sp2 += P[2 * k] * n0; sp2 += P[2 * k + 1] * n1; } }
            const float sa = sa2[0] + sa2[1], sp = sp2[0] + sp2[1];
            const f32x2 sav = {sa, sa}, spv = {sp, sp}, vvv = {vv, vv};
            f32x2 y2 = {0.f, 0.f};
#pragma unroll
            for (int k = 0; k < 16; ++k) { const f32x4 w4 = *(const f32x4*)(o + 4 * k), b4 = *(const f32x4*)(o + 64 + 4 * k), k4 = *(const f32x4*)(o + 128 + 4 * k);
                const f32x2 w0 = {w4[0], w4[1]}, w1 = {w4[2], w4[3]}, b0 = {b4[0], b4[1]}, b1 = {b4[2], b4[3]}, d0 = {k4[0], k4[1]}, d1 = {k4[2], k4[3]};
                S[2 * k] = S[2 * k] * w0 + sav * b0 + vvv * d0; S[2 * k + 1] = S[2 * k + 1] * w1 + sav * b1 + vvv * d1;
                if (PASS == 1) { P[2 * k] = P[2 * k] * w0 + spv * b0; P[2 * k + 1] = P[2 * k + 1] * w1 + spv * b1; }
                if (PASS == 2) { const f32x4 r4 = *(const f32x4*)(o + 256 + 4 * k); const f32x2 r0 = {r4[0], r4[1]}, r1 = {r4[2], r4[3]}; y2 += S[2 * k] * r0; y2 += S[2 * k + 1] * r1; } }
            if (PASS == 2) { const int jj = R.d == 0 ? sb * RW_T + j : RW_LC - 1 - (sb * RW_T + j); const size_t row = (size_t)R.b * SEQ + R.c * RW_LC + jj;
                wkv[((size_t)R.d * MR + row) * 256 + h * 64 + lane] = y2[0] + y2[1]; }
        }
        __syncthreads();
    }
    if (PASS == 1) {
#pragma unroll
        for (int k = 0; k < 16; ++k) { *(f32x4*)(slot + lane * 64 + 4 * k) = (f32x4){P[2 * k][0], P[2 * k][1], P[2 * k + 1][0], P[2 * k + 1][1]};
            *(f32x4*)(slot + 4096 + lane * 64 + 4 * k) = (f32x4){S[2 * k][0], S[2 * k][1], S[2 * k + 1][0], S[2 * k + 1][1]}; }
    }
}
DEV void rw_passB(PP p, float* lds) {
    const int tid = otid(), wave = __builtin_amdgcn_readfirstlane(tid >> 6), lane = tid & 63, i16 = lane & 15, kq = lane >> 4;
    float* Sl = lds; float* Pl = lds + 64 * 68; float* pe = (float*)(p->ws + WS_PE);
    for (int chain = blockIdx.x; chain < 32; chain += gridDim.x) {
        __syncthreads();
#pragma unroll
        for (int e = 0; e < 8; ++e) { const int idx = e * 512 + tid; Sl[(idx >> 6) * 68 + (idx & 63)] = 0.f; }
        float pr[8]; f32x4 er[2];
        { const float* slot = pe + ((size_t)chain * RW_NC) * 8192;
#pragma unroll
          for (int e = 0; e < 8; ++e) pr[e] = slot[e * 512 + tid];
#pragma unroll
          for (int q = 0; q < 2; ++q) { const int id = wave + 8 * q, rt = id >> 2, ct = id & 3;
#pragma unroll
              for (int r = 0; r < 4; ++r) er[q][r] = slot[4096 + (16 * rt + kq * 4 + r) * 64 + 16 * ct + i16]; } }
        for (int sc = 0; sc < RW_NC; ++sc) {
            float* slot = pe + ((size_t)chain * RW_NC + sc) * 8192;
#pragma unroll
            for (int e = 0; e < 8; ++e) { const int idx = e * 512 + tid; Pl[(idx >> 6) * 72 + (idx & 63)] = pr[e]; }
            __syncthreads();
            f32x4 acc[2] = {er[0], er[1]};
            if (sc + 1 < RW_NC) { const float* nslot = slot + 8192;
#pragma unroll
                for (int e = 0; e < 8; ++e) pr[e] = nslot[e * 512 + tid];
#pragma unroll
                for (int q = 0; q < 2; ++q) { const int id = wave + 8 * q, rt = id >> 2, ct = id & 3;
#pragma unroll
                    for (int r = 0; r < 4; ++r) er[q][r] = nslot[4096 + (16 * rt + kq * 4 + r) * 64 + 16 * ct + i16]; } }
#pragma unroll
            for (int q = 0; q < 2; ++q) { const int id = wave + 8 * q, rt = id >> 2, ct = id & 3;
                acc[q] = mm16(Sl + 16 * rt * 68, 68, 1, Pl + 16 * ct, 72, 1, 0, 64, acc[q], lane);
#pragma unroll
                for (int r = 0; r < 4; ++r) { const int row = 16 * rt + kq * 4 + r, col = 16 * ct + i16; slot[4096 + row * 64 + col] = Sl[row * 68 + col]; } }
            __syncthreads();
#pragma unroll
            for (int q = 0; q < 2; ++q) { const int id = wave + 8 * q, rt = id >> 2, ct = id & 3;
#pragma unroll
                for (int r = 0; r < 4; ++r) Sl[(16 * rt + kq * 4 + r) * 68 + 16 * ct + i16] = acc[q][r]; }
        }
    }
}
DEV void rw_final(PP p, int l, float* lds) {
    const int tid = otid(), tg = tid >> 8, c = tid & 255, h = c >> 6;
    const bf16_t* z = (const bf16_t*)(p->ws + WS_BIG); bf16_t* Y = (bf16_t*)(p->ws + WS_XB);
    const float* mu = p->in[10] + l * 960; const float* g2 = p->in[15] + l * 16384; const float* wkv = (const float*)(p->ws + WS_WKV); const float* sbon = (const float*)(p->ws + WS_SBON);
    const float lnw = p->in[19][l * 256 + c], lnb = p->in[20][l * 256 + c];
    float g2r[64];
#pragma unroll
    for (int r = 0; r < 64; ++r) g2r[r] = g2[r * 256 + c];
    float* sgl = lds;
    for (int tile = blockIdx.x; tile < MR / 32; tile += gridDim.x) {
        const int row0 = tile * 32;
#pragma unroll
        for (int e = 0; e < 4; ++e) { const int idx = e * 512 + tid, tok = idx >> 6, r = idx & 63; const int row = row0 + tok;
            sgl[tok * 64 + r] = sigmoid_f(rw_shift(z, row, row & (SEQ - 1), 896 + r, mu)); }
        __syncthreads();
        for (int q = 0; q < 16; ++q) { const int tok = tg * 16 + q; const size_t row = row0 + tok; const int t = (int)(row & (SEQ - 1));
            float gate = 0.f;
#pragma unroll
            for (int r = 0; r < 64; ++r) gate += sgl[tok * 64 + r] * g2r[r];
            const float wk = wkv[row * 256 + c] + wkv[((size_t)MR + row) * 256 + c];
            const float mean = wave_sum(wk) * (1.f / 64.f); const float dv = wk - mean; const float var = wave_sum(dv * dv) * (1.f / 64.f);
            const float nrm = dv * rsqrtf(var + 64e-5f);
            const float vsh = rw_shift(z, row, t, 512 + c, mu);
            const float bon = (sbon[row * 4 + h] + sbon[((size_t)MR + row) * 4 + h]) * vsh;
            const float out = (nrm * lnw + lnb + bon) * gate;
            Y[row * DM + 512 + c] = (bf16_t)f2bf(out); }
        __syncthreads();
    }
}

#ifndef REP_RW
#define REP_RW 1
#endif
#ifndef REP_MIX
#define REP_MIX 1
#endif
DEV void mix_items(PP p, int l, int pass, float* ldsf) {
    unsigned char* ws = p->ws; const bf16_t* BIG = (const bf16_t*)(ws + WS_BIG); bf16_t* XB = (bf16_t*)(ws + WS_XB);
    for (int it = blockIdx.x; it < 2 * NB * NH * NCH; it += gridDim.x) { MixCtx m; const int mode = it >= NB * NH * NCH; const int r = it - mode * NB * NH * NCH;
        m.mode = mode; m.z = BIG; m.rope = (const float*)(ws + WS_ROPE); m.b = r / (NH * NCH); m.h = (r / NCH) % NH; m.c = r % NCH;
        { const float x0 = p->in[9][l * 8 + m.h], x1 = p->in[9][l * 8 + 4 + m.h];
          m.lg0 = fminf(x0, 0.f) - log1pf(__expf(-fabsf(x0))); m.lg1 = fminf(x1, 0.f) - log1pf(__expf(-fabsf(x1)));
          m.ib0 = p->in[21][l * 8 + m.h]; m.ib1 = p->in[21][l * 8 + 4 + m.h]; m.fb0 = p->in[22][l * 8 + m.h]; m.fb1 = p->in[22][l * 8 + 4 + m.h]; }
        if (pass == 0) mix_passA(m, ldsf, (float*)(ws + (mode ? WS_MLC : WS_RET)), (float*)(ws + WS_MLN), (float*)(ws + WS_MLS));
        else mix_passC(m, ldsf, (const float*)(ws + (mode ? WS_MLC : WS_RET)), (const float*)(ws + WS_MLN), (const float*)(ws + WS_MLS), XB, p->in[23] + l * 256); }
}
__global__ void __launch_bounds__(512, 2) mega_fwd(Params pdummy) {
    extern __shared__ __attribute__((aligned(16))) unsigned char lds_raw[];
    cg::grid_group grid = cg::this_grid();
    float* ldsf = (float*)lds_raw; PG8_LAS unsigned char* ldsg = (PG8_LAS unsigned char*)lds_raw;
    { PP p = fresh_params(); unsigned char* ws = p->ws;
      convert_weights(p, 0, ldsf);
      float* rope = (float*)(ws + WS_ROPE); const int tid = otid();
      for (int i = blockIdx.x * 512 + tid; i < SEQ * 32; i += gridDim.x * 512) { const int t = i >> 5, k = i & 31;
          const float inv = powf(10000.f, -(float)(2 * k) / 64.f); const float ang = (float)t * inv;
          const double ad = (double)ang; const double rev = ad * 0.15915494309189535; const double fr = rev - rint(rev); const float rr = (float)(fr * 6.283185307179586);
          (void)rr; rope[i] = __builtin_amdgcn_cosf((float)fr); rope[SEQ * 32 + i] = __builtin_amdgcn_sinf((float)fr); }
      row_phase(p->in[0], p->out, nullptr, nullptr, 0.f, p->in[1], (bf16_t*)(ws + WS_XB)); }
    grid.sync();
    for (int ph = 0; ph < 26; ++ph) {
        const int phu = __builtin_amdgcn_readfirstlane(ph);
        const int l = phu >= 13 ? 1 : 0, k = phu - 13 * l;
        PP p = fresh_params(); unsigned char* ws = p->ws; const int G = gridDim.x;
        bf16_t* XB = (bf16_t*)(ws + WS_XB); bf16_t* BIG = (bf16_t*)(ws + WS_BIG); bf16_t* DB = (bf16_t*)(ws + WS_D);
        const float* g = p->in[1] + (size_t)l * 6 * DM;
        if (k == 0 || k == 10) {
            const int f = k == 10;
            pg8::Gemm gm{XB, (const bf16_t*)(ws + WS_WGU + (size_t)f * 11 * MiB), MR, 2 * DFF, DM}; pg8::StaticOrder S; S.init(MR, 2 * DFF, G, (int)blockIdx.x); pg8::EpiSwiGLU E{BIG, DFF};
            pg8::gemm_phase<pg8::EpiSwiGLU, pg8::StaticOrder, true, true>(ldsg, gm, S, E);
        } else if (k == 1 || k == 11 || k == 3 || k == 8) {
            const bf16_t* A; const bf16_t* Bt; bf16_t* O; int N, K;
            if (k == 3) { A = XB; Bt = (const bf16_t*)(ws + WS_WIN); O = BIG; N = ZLD; K = DM; }
            else if (k == 8) { A = XB; Bt = (const bf16_t*)(ws + WS_WOUT); O = DB; N = DM; K = DM; }
            else { A = BIG; Bt = (const bf16_t*)(ws + WS_WD + (size_t)(k == 11) * (11 * MiB / 2)); O = DB; N = DM; K = DFF; }
            pg8::Gemm gm{A, Bt, MR, N, K}; pg8::StaticOrder S; S.init(MR, N, G, (int)blockIdx.x); pg8::EpiBf16 E{O, N};
            pg8::gemm_phase<pg8::EpiBf16, pg8::StaticOrder, true, true>(ldsg, gm, S, E);
        } else if (k == 2) { row_phase(p->out, p->out, DB, g + 1 * DM, 0.5f, g + 2 * DM, XB);
        } else if (k == 9) { row_phase(p->out, p->out, DB, g + 3 * DM, 1.0f, g + 4 * DM, XB);
        } else if (k == 12) { row_phase(p->out, p->out, DB, g + 5 * DM, 0.5f, l == 0 ? g + 6 * DM : nullptr, l == 0 ? XB : nullptr);
            if (l == 0) convert_weights(p, 1, ldsf);
        } else if (k == 4) {
            for (int rep = 0; rep < REP_RW; ++rep) { for (int task = blockIdx.x; task < NB * RW_NC * 2; task += G) rw_task<1>(p, l, task, ldsf);
            __syncthreads(); }
            for (int rep = 0; rep < REP_MIX; ++rep) mix_items(p, l, 0, ldsf);
            conv_mixer(p, l, BIG, XB);
        } else if (k == 5) { rw_passB(p, ldsf); mix_passB(p, l, ldsf + 64 * 68 + 64 * 72);
        } else if (k == 6) {
            for (int rep = 0; rep < REP_RW; ++rep) { for (int task = blockIdx.x; task < NB * RW_NC * 2; task += G) rw_task<2>(p, l, task, ldsf);
            __syncthreads(); }
            for (int rep = 0; rep < REP_MIX; ++rep) mix_items(p, l, 1, ldsf);
        } else { rw_final(p, l, ldsf); }
        if (ph != 25) grid.sync();
    }
}

extern "C" void kernel_launch(void* const* d_in, const int* in_sizes, int n_in, void* d_out, int out_size, void* d_ws, size_t ws_size, hipStream_t stream) {
    static int grid = 0;
    if (grid == 0) {
        int dev = 0, cus = 0, per_cu = 0;
        (void)hipGetDevice(&dev); (void)hipDeviceGetAttribute(&cus, hipDeviceAttributeMultiprocessorCount, dev);
        (void)hipFuncSetAttribute((const void*)mega_fwd, hipFuncAttributeMaxDynamicSharedMemorySize, LDS_BYTES);
        (void)hipOccupancyMaxActiveBlocksPerMultiprocessor(&per_cu, (const void*)mega_fwd, 512, LDS_BYTES);
        if (per_cu < 1) fprintf(stderr, "occupancy query says %d blocks/CU\n", per_cu);
        (void)hipGetLastError();
        grid = cus;
        if (ws_size < WS_END) fprintf(stderr, "kernel_launch: workspace too small: %zu < %zu\n", ws_size, (size_t)WS_END);
    }
    Params p{};
    for (int i = 0; i < 24; ++i) p.in[i] = (const float*)d_in[i];
    p.out = (float*)d_out; p.ws = (unsigned char*)d_ws;
    void* args[] = {&p};
    hipError_t e = hipLaunchCooperativeKernel((const void*)mega_fwd, dim3(grid), dim3(512), args, LDS_BYTES, stream);
    if (e != hipSuccess) fprintf(stderr, "cooperative launch failed: %s (grid %d)\n", hipGetErrorString(e), grid);
}
```

```cpp
#include <hip/hip_runtime.h>
#include <hip/hip_cooperative_groups.h>
#include <cstdio>
#include <cstdint>
namespace cg = cooperative_groups;
namespace pg8 {
#define PG8_LAS __attribute__((address_space(3)))
typedef unsigned short bf16_t;
typedef short bf16x8 __attribute__((ext_vector_type(8)));
typedef float f32x4 __attribute__((ext_vector_type(4)));
typedef unsigned u32x4 __attribute__((ext_vector_type(4)));
constexpr int BM = 256, BK = 64, HALF = 128, HTB = HALF * BK * 2, STAGE_BYTES = 8 * HTB, NXCD = 8, WGM = 8;
__host__ __device__ __forceinline__ int lds_byte(int r, int c) { const int st = (r >> 4) * 2 + (c >> 5), rr = r & 15, cc = c & 31, ob = rr * 64 + cc * 2; return st * 1024 + (ob ^ (((ob >> 9) & 1) << 5)); }
__host__ __device__ __forceinline__ void stage_rc(int b, int& R, int& C) { const int st = b / 1024, sb = b % 1024, swz = sb ^ (((sb >> 9) & 1) << 5); R = (st >> 1) * 16 + swz / 64; C = (st & 1) * 32 + (swz % 64) / 2; }
__host__ __device__ __forceinline__ int perm32(int rho) { const int n = rho >> 4, i = rho & 15; return 8 * (i >> 2) + 4 * n + (i & 3); }
struct Unit { int pm, pn; };
struct Gemm { const bf16_t* A; const bf16_t* Bt; int M, N, K; };
struct StaticOrder {
    int nM, nN, nwg, G, c;
    __host__ __device__ void init(int M, int N, int G_, int c_) { nM = M / BM; nN = N / BM; nwg = nM * nN; G = G_; c = c_; }
    __host__ __device__ bool next(int i, Unit& u) const {
        const long L = (long)i * G + c; if (L >= nwg) return false;
        int wgid = (int)L; { const int q = nwg / NXCD, r = nwg % NXCD, xcd = wgid % NXCD, off = wgid / NXCD; wgid = (xcd < r ? xcd * (q + 1) : r * (q + 1) + (xcd - r) * q) + off; }
        const int nig = WGM * nN, gid = wgid / nig, fm = gid * WGM, gsz = (nM - fm) < WGM ? (nM - fm) : WGM;
        u.pm = fm + ((wgid % nig) % gsz); u.pn = (wgid % nig) / gsz; return true;
    }
    __device__ __forceinline__ void a_ready(const Unit&) const {}
    __device__ __forceinline__ void done(const Unit&) const {}
};
__device__ __forceinline__ unsigned cvt_pk_bf16(float lo, float hi) { unsigned r; asm volatile("v_cvt_pk_bf16_f32 %0, %1, %2" : "=v"(r) : "v"(lo), "v"(hi)); return r; }
struct EpiBf16 {
    static constexpr bool PERM = true, AFTER_DRAIN = false;
    bf16_t* O; int ldc;
    __device__ __forceinline__ void operator()(const f32x4 (&acc)[2][2][4][2], const Unit& u, int wr, int wc, int fr, int fq) const {
        const int row0 = u.pm * BM + wr * 64 + fr; const int col0 = u.pn * BM + wc * 32 + 8 * fq;
#pragma unroll
        for (int ai = 0; ai < 2; ++ai)
#pragma unroll
            for (int m = 0; m < 4; ++m) { bf16_t* rowp = O + (size_t)(row0 + ai * HALF + m * 16) * ldc + col0;
#pragma unroll
                for (int bj = 0; bj < 2; ++bj) { const f32x4 v0 = acc[ai][bj][m][0], v1 = acc[ai][bj][m][1];
                    u32x4 w; w.x = cvt_pk_bf16(v0[0], v0[1]); w.y = cvt_pk_bf16(v0[2], v0[3]); w.z = cvt_pk_bf16(v1[0], v1[1]); w.w = cvt_pk_bf16(v1[2], v1[3]);
                    *(u32x4*)(rowp + bj * HALF) = w; } }
    }
};
__device__ __forceinline__ float silu_f(float g) { return g * __builtin_amdgcn_rcpf(1.0f + __expf(-g)); }
struct EpiSwiGLU {
    static constexpr bool PERM = true, AFTER_DRAIN = false;
    bf16_t* O; int ldc;
    __device__ __forceinline__ void operator()(const f32x4 (&acc)[2][2][4][2], const Unit& u, int wr, int wc, int fr, int fq) const {
        const int row0 = u.pm * BM + wr * 64 + fr; const int col0 = u.pn * HALF + wc * 32 + 8 * fq;
#pragma unroll
        for (int ai = 0; ai < 2; ++ai)
#pragma unroll
            for (int m = 0; m < 4; ++m) { bf16_t* rowp = O + (size_t)(row0 + ai * HALF + m * 16) * ldc + col0;
                const f32x4 g0 = acc[ai][0][m][0], g1 = acc[ai][0][m][1], u0 = acc[ai][1][m][0], u1 = acc[ai][1][m][1];
                u32x4 w;
                w.x = cvt_pk_bf16(silu_f(g0[0]) * u0[0], silu_f(g0[1]) * u0[1]); w.y = cvt_pk_bf16(silu_f(g0[2]) * u0[2], silu_f(g0[3]) * u0[3]);
                w.z = cvt_pk_bf16(silu_f(g1[0]) * u1[0], silu_f(g1[1]) * u1[1]); w.w = cvt_pk_bf16(silu_f(g1[2]) * u1[2], silu_f(g1[3]) * u1[3]);
                *(u32x4*)rowp = w; }
    }
};
template <class Epi, class Sched, bool ALIGN_EPI = false, bool SP2 = false>
__device__ __forceinline__ void gemm_phase(PG8_LAS unsigned char* lds, const Gemm g, const Sched& S, const Epi& E) {
    int tid = threadIdx.x; asm volatile("" : "+v"(tid)); const int wid = __builtin_amdgcn_readfirstlane(tid >> 6), lane = tid & 63, wr = wid >> 2, wc = wid & 3, fr = lane & 15, fq = lane >> 4;
    const int K = g.K, nt = K / BK;
    unsigned voffA[2], voffB[2];
#pragma unroll
    for (int i = 0; i < 2; ++i) { int R, C; stage_rc(tid * 16 + i * 8192, R, C); const int Rb = Epi::PERM ? ((R & ~31) + perm32(R & 31)) : R;
        voffA[i] = (unsigned)(R * K + C) * 2u; voffB[i] = (unsigned)(Rb * K + C) * 2u; }
    const size_t kstep = (size_t)(BK * 2);
    const size_t hstep = (size_t)HALF * K * 2;
    const size_t tstep = 2 * hstep;
    const unsigned ldsw = (unsigned)wid * 1024u;
    const int aoff = lds_byte(wr * 64 + fr, fq * 8), boff = lds_byte(wc * 32 + fr, fq * 8);
#define PG8_SA(b, h) (((b) * 2 + (h)) * HTB)
#define PG8_SB(b, h) ((4 + (b) * 2 + (h)) * HTB)
#define PG8_STAGE(bufoff, gbase, voff) do { _Pragma("unroll") for (int _i = 0; _i < 2; ++_i) \
        __builtin_amdgcn_global_load_lds((const unsigned*)((const char*)(gbase) + (voff)[_i]), (PG8_LAS unsigned*)(lds + (bufoff) + ldsw + _i * 8192), 16, 0, 0); } while (0)
#define PG8_LDA(dst, b, h) do { _Pragma("unroll") for (int m = 0; m < 4; ++m) _Pragma("unroll") for (int k = 0; k < 2; ++k) dst[m][k] = *(const PG8_LAS bf16x8*)(lds + PG8_SA(b, h) + aoff + m * 2048 + k * 1024); } while (0)
#define PG8_LDB(dst, b, h) do { _Pragma("unroll") for (int n = 0; n < 2; ++n) _Pragma("unroll") for (int k = 0; k < 2; ++k) dst[n][k] = *(const PG8_LAS bf16x8*)(lds + PG8_SB(b, h) + boff + n * 2048 + k * 1024); } while (0)
#define PG8_MMA(ai, bj, At, Bt) do { __builtin_amdgcn_s_setprio(1); _Pragma("unroll") for (int m = 0; m < 4; ++m) _Pragma("unroll") for (int n = 0; n < 2; ++n) _Pragma("unroll") for (int k = 0; k < 2; ++k) \
        acc[ai][bj][m][n] = __builtin_amdgcn_mfma_f32_16x16x32_bf16(Bt[n][k], At[m][k], acc[ai][bj][m][n], 0, 0, 0); __builtin_amdgcn_s_setprio(0); } while (0)
#define PG8_WAIT_V(n) asm volatile("s_waitcnt vmcnt(" #n ")" ::: "memory")
#define PG8_WAIT_L(n) asm volatile("s_waitcnt lgkmcnt(" #n ")" ::: "memory")
#define PG8_BAR __builtin_amdgcn_s_barrier()
#define PG8_SCHED __builtin_amdgcn_sched_barrier(0)
    Unit cur, nxt; int ui = 0;
    if (!S.next(0, cur)) return;
    f32x4 acc[2][2][4][2];
#pragma unroll
    for (int a = 0; a < 2; ++a)
#pragma unroll
        for (int b = 0; b < 2; ++b)
#pragma unroll
            for (int m = 0; m < 4; ++m)
#pragma unroll
                for (int n = 0; n < 2; ++n) acc[a][b][m][n] = (f32x4){0.f, 0.f, 0.f, 0.f};
    bf16x8 At[4][2], B0[2][2], B1[2][2];
    const char* cA = (const char*)g.A + (size_t)cur.pm * tstep; const char* cB = (const char*)g.Bt + (size_t)cur.pn * tstep;
    S.a_ready(cur);
    if constexpr (SP2) {
        PG8_STAGE(PG8_SB(0, 0), cB, voffB); PG8_STAGE(PG8_SB(0, 1), cB + hstep, voffB); PG8_STAGE(PG8_SA(0, 0), cA, voffA); PG8_STAGE(PG8_SA(0, 1), cA + hstep, voffA);
        if (wr == 1) PG8_BAR;
        PG8_WAIT_V(2); PG8_BAR;
        PG8_STAGE(PG8_SB(1, 0), cB + kstep, voffB); PG8_STAGE(PG8_SA(1, 0), cA + kstep, voffA); PG8_STAGE(PG8_SB(1, 1), cB + hstep + kstep, voffB);
        PG8_WAIT_V(6); PG8_BAR;
    } else {
        PG8_STAGE(PG8_SB(0, 0), cB, voffB); PG8_STAGE(PG8_SA(0, 0), cA, voffA); PG8_STAGE(PG8_SB(0, 1), cB + hstep, voffB); PG8_STAGE(PG8_SA(0, 1), cA + hstep, voffA);
        if (wr == 1) PG8_BAR;
        PG8_WAIT_V(4); PG8_BAR;
        PG8_STAGE(PG8_SB(1, 0), cB + kstep, voffB); PG8_STAGE(PG8_SA(1, 0), cA + kstep, voffA); PG8_STAGE(PG8_SB(1, 1), cB + hstep + kstep, voffB);
        PG8_WAIT_V(6); PG8_BAR;
    }
    for (;;) {
        const bool has_next = S.next(ui + 1, nxt);
        const char* nA = has_next ? (const char*)g.A + (size_t)nxt.pm * tstep : cA; const char* nB = has_next ? (const char*)g.Bt + (size_t)nxt.pn * tstep : cB;
        for (int t = 0; t < nt; t += 2) {
            const bool last = (t == nt - 2);
            const char* a1 = cA + (size_t)(t + 1) * kstep;
            const char* a2 = last ? nA : cA + (size_t)(t + 2) * kstep; const char* b2 = last ? nB : cB + (size_t)(t + 2) * kstep;
            const char* a3 = a2 + kstep; const char* b3 = b2 + kstep;
            if (last && has_next) S.a_ready(nxt);
            if constexpr (SP2) {
            PG8_LDB(B0, 0, 0); PG8_LDB(B1, 0, 1); PG8_SCHED; PG8_LDA(At, 0, 0); PG8_STAGE(PG8_SA(1, 1), a1 + hstep, voffA);
            PG8_WAIT_V(8); PG8_WAIT_L(0); PG8_BAR; PG8_MMA(0, 0, At, B0); PG8_MMA(0, 1, At, B1); PG8_BAR; PG8_SCHED;
            PG8_LDA(At, 0, 1); PG8_STAGE(PG8_SB(0, 0), b2, voffB); PG8_STAGE(PG8_SB(0, 1), b2 + hstep, voffB); PG8_STAGE(PG8_SA(0, 0), a2, voffA);
            PG8_WAIT_V(8); PG8_WAIT_L(0); PG8_BAR; PG8_MMA(1, 0, At, B0); PG8_MMA(1, 1, At, B1); PG8_BAR; PG8_SCHED;
            PG8_LDB(B0, 1, 0); PG8_LDB(B1, 1, 1); PG8_SCHED; PG8_LDA(At, 1, 0); PG8_STAGE(PG8_SA(0, 1), a2 + hstep, voffA);
            PG8_WAIT_V(8); PG8_WAIT_L(0); PG8_BAR; PG8_MMA(0, 0, At, B0); PG8_MMA(0, 1, At, B1); PG8_BAR; PG8_SCHED;
            PG8_LDA(At, 1, 1); PG8_STAGE(PG8_SB(1, 0), b3, voffB); PG8_STAGE(PG8_SB(1, 1), b3 + hstep, voffB); PG8_STAGE(PG8_SA(1, 0), a3, voffA);
            PG8_WAIT_V(8); PG8_WAIT_L(0); PG8_BAR; PG8_MMA(1, 0, At, B0); PG8_MMA(1, 1, At, B1); PG8_BAR; PG8_SCHED;
            } else {
            PG8_LDB(B0, 0, 0); PG8_SCHED; PG8_LDA(At, 0, 0); PG8_STAGE(PG8_SA(1, 1), a1 + hstep, voffA);
            PG8_WAIT_L(8); PG8_BAR; PG8_WAIT_L(0); PG8_MMA(0, 0, At, B0); PG8_BAR; PG8_SCHED;
            PG8_LDB(B1, 0, 1); PG8_STAGE(PG8_SB(0, 0), b2, voffB);
            PG8_BAR; PG8_WAIT_L(0); PG8_MMA(0, 1, At, B1); PG8_BAR;
            PG8_LDA(At, 0, 1); PG8_STAGE(PG8_SA(0, 0), a2, voffA);
            PG8_BAR; PG8_WAIT_L(0); PG8_MMA(1, 0, At, B0); PG8_BAR; PG8_SCHED;
            PG8_STAGE(PG8_SB(0, 1), b2 + hstep, voffB);
            PG8_WAIT_V(6); PG8_BAR; PG8_MMA(1, 1, At, B1); PG8_BAR;
            PG8_LDB(B0, 1, 0); PG8_SCHED; PG8_LDA(At, 1, 0); PG8_STAGE(PG8_SA(0, 1), a2 + hstep, voffA);
            PG8_WAIT_L(8); PG8_BAR; PG8_WAIT_L(0); PG8_MMA(0, 0, At, B0); PG8_BAR; PG8_SCHED;
            PG8_LDB(B1, 1, 1); PG8_STAGE(PG8_SB(1, 0), b3, voffB);
            PG8_BAR; PG8_WAIT_L(0); PG8_MMA(0, 1, At, B1); PG8_BAR;
            PG8_LDA(At, 1, 1); PG8_STAGE(PG8_SA(1, 0), a3, voffA);
            PG8_BAR; PG8_WAIT_L(0); PG8_MMA(1, 0, At, B0); PG8_BAR; PG8_SCHED;
            PG8_STAGE(PG8_SB(1, 1), b3 + hstep, voffB);
            PG8_WAIT_V(6); PG8_BAR; PG8_MMA(1, 1, At, B1); PG8_BAR;
            }
        }
        if constexpr (ALIGN_EPI) { if (wr == 0) PG8_BAR; }
        if constexpr (!Epi::AFTER_DRAIN) { E(acc, cur, wr, wc, fr, fq); S.done(cur); }
        if (!has_next) break;
#pragma unroll
        for (int a = 0; a < 2; ++a)
#pragma unroll
            for (int b = 0; b < 2; ++b)
#pragma unroll
                for (int m = 0; m < 4; ++m)
#pragma unroll
                    for (int n = 0; n < 2; ++n) acc[a][b][m][n] = (f32x4){0.f, 0.f, 0.f, 0.f};
        cur = nxt; cA = nA; cB = nB; ++ui;
        if constexpr (ALIGN_EPI) { if (wr == 1) PG8_BAR; }
    }
    PG8_WAIT_V(0);
    if constexpr (!ALIGN_EPI) { if (wr == 0) PG8_BAR; }
    PG8_BAR;
    if constexpr (Epi::AFTER_DRAIN) { E.fused(acc, cur, wr, wc, fr, fq, lds, wid, lane); S.done(cur); }
#undef PG8_SA
#undef PG8_SB
#undef PG8_STAGE
#undef PG8_LDA
#undef PG8_LDB
#undef PG8_MMA
#undef PG8_WAIT_V
#undef PG8_WAIT_L
#undef PG8_BAR
#undef PG8_SCHED
}
}

#define DEV __device__ __forceinline__
typedef unsigned short bf16_t;
typedef float f32x4 __attribute__((ext_vector_type(4)));
typedef float f32x2 __attribute__((ext_vector_type(2)));
typedef unsigned u32x4 __attribute__((ext_vector_type(4)));
typedef unsigned u32x2 __attribute__((ext_vector_type(2)));
constexpr int MR = 32768, SEQ = 8192, DM = 1024, DFF = 2816, PT = 3792, ZLD = 3840, NB = 4, NH = 4;
constexpr float RMS_EPS = 1e-6f;
constexpr size_t MiB = 1u << 20;
constexpr size_t WS_WGU = 1 * MiB, WS_WD = 23 * MiB, WS_WIN = 34 * MiB, WS_WOUT = 42 * MiB, WS_ROPE = 44 * MiB;
constexpr size_t WS_XB = 46 * MiB, WS_BIG = 110 * MiB, WS_SCR = 350 * MiB;
constexpr size_t WS_D = WS_SCR;
constexpr size_t WS_RET = WS_SCR, WS_MLC = WS_SCR + 32 * MiB, WS_MLN = WS_SCR + 64 * MiB, WS_MLS = WS_SCR + 64 * MiB + 512 * 1024;
constexpr size_t WS_PE = WS_SCR + 65 * MiB, WS_WKV = WS_SCR + 97 * MiB, WS_SBON = WS_SCR + 161 * MiB, WS_END = 512 * MiB;
constexpr int LDS_BYTES = 163840;
constexpr int RW_LC = 256, RW_NC = SEQ / RW_LC, RW_T = 8;
constexpr int CH = 128, NCH = SEQ / CH;

struct Params { const float* in[24]; float* out; unsigned char* ws; };
typedef const __attribute__((address_space(4))) Params* PP;
DEV PP fresh_params() { PP q = (PP)__builtin_amdgcn_kernarg_segment_ptr(); asm volatile("" : "+s"(q)); return q; }
DEV int otid() { int t = threadIdx.x; asm volatile("" : "+v"(t)); return t; }

DEV float bf2f(bf16_t v) { return __uint_as_float(((unsigned)v) << 16); }
DEV unsigned f2bf(float f) { unsigned u = __float_as_uint(f); return (u + 0x7fffu + ((u >> 16) & 1u)) >> 16; }
DEV unsigned pk2(float lo, float hi) { return f2bf(lo) | (f2bf(hi) << 16); }
template <int CTRL> DEV float dppf(float v) { return __int_as_float(__builtin_amdgcn_update_dpp(0, __float_as_int(v), CTRL, 0xf, 0xf, true)); }
DEV float wave_sum(float v) {
    v += dppf<0xB1>(v); v += dppf<0x4E>(v); v += dppf<0x141>(v); v += dppf<0x140>(v);
    const int vi = __float_as_int(v);
    return (__int_as_float(__builtin_amdgcn_readlane(vi, 0)) + __int_as_float(__builtin_amdgcn_readlane(vi, 16))) + (__int_as_float(__builtin_amdgcn_readlane(vi, 32)) + __int_as_float(__builtin_amdgcn_readlane(vi, 48)));
}
DEV float sigmoid_f(float x) { return 1.0f / (1.0f + __expf(-x)); }
DEV float softplus_f(float x) { return fmaxf(x, 0.f) + __logf(1.0f + __expf(-fabsf(x))); }
DEV float tanh_f(float x) { return 1.0f - 2.0f * __builtin_amdgcn_rcpf(1.0f + __expf(2.0f * x)); }
DEV void unpack8(const u32x4 w, float* f) {
    f[0] = __uint_as_float(w.x << 16); f[1] = __uint_as_float(w.x & 0xffff0000u); f[2] = __uint_as_float(w.y << 16); f[3] = __uint_as_float(w.y & 0xffff0000u);
    f[4] = __uint_as_float(w.z << 16); f[5] = __uint_as_float(w.z & 0xffff0000u); f[6] = __uint_as_float(w.w << 16); f[7] = __uint_as_float(w.w & 0xffff0000u);
}

DEV void conv_tile(const float* W, int K, int N, bf16_t* WT, int mode, int tile, float* scr) {
    const int nkt = K >> 6; const int kt = tile % nkt, nt = tile / nkt, k0 = kt * 64, n0 = nt * 64, tid = otid();
#pragma unroll
    for (int e = 0; e < 8; ++e) { const int idx = e * 512 + tid, kk = idx >> 6, nn = idx & 63;
        const float v = (n0 + nn < N) ? W[(size_t)(k0 + kk) * N + n0 + nn] : 0.f; scr[nn * 65 + kk] = v; }
    __syncthreads();
    { const int nn = tid >> 3, c8 = tid & 7; const float* s = scr + nn * 65 + c8 * 8; const int n = n0 + nn;
      const int drow = mode == 0 ? n : ((n >> 7) * 256 + (n & 127) + (mode == 2 ? 128 : 0));
      u32x4 o; o.x = pk2(s[0], s[1]); o.y = pk2(s[2], s[3]); o.z = pk2(s[4], s[5]); o.w = pk2(s[6], s[7]);
      *(u32x4*)(WT + (size_t)drow * K + k0 + c8 * 8) = o; }
    __syncthreads();
}
DEV void convert_weights(PP p, int l, float* scr) {
    unsigned char* ws = p->ws;
    const int T_GU = 16 * 44, T_D = 44 * 16, T_IN = 16 * 60, T_OUT = 16 * 16;
    const int total = 4 * T_GU + 2 * T_D + T_IN + T_OUT;
    for (int it = blockIdx.x; it < total; it += gridDim.x) {
        int r = it;
        if (r < 4 * T_GU) { const int f = r / (2 * T_GU), which = (r / T_GU) & 1, t = r % T_GU;
            const float* W = p->in[which ? 3 : 2] + (size_t)(l * 2 + f) * DM * DFF;
            conv_tile(W, DM, DFF, (bf16_t*)(ws + WS_WGU + (size_t)f * 11 * MiB), which ? 2 : 1, t, scr); continue; }
        r -= 4 * T_GU;
        if (r < 2 * T_D) { const int f = r / T_D, t = r % T_D;
            conv_tile(p->in[4] + (size_t)(l * 2 + f) * DFF * DM, DFF, DM, (bf16_t*)(ws + WS_WD + (size_t)f * (11 * MiB / 2)), 0, t, scr); continue; }
        r -= 2 * T_D;
        if (r < T_IN) { conv_tile(p->in[5] + (size_t)l * DM * PT, DM, PT, (bf16_t*)(ws + WS_WIN), 0, r, scr); continue; }
        r -= T_IN;
        conv_tile(p->in[6] + (size_t)l * DM * DM, DM, DM, (bf16_t*)(ws + WS_WOUT), 0, r, scr);
    }
}
DEV void row_phase(const float* xin, float* xout, const bf16_t* d, const float* gA, float coef, const float* gB, bf16_t* xb) {
    const int tid_ = otid(); const int lane = tid_ & 63, gw = blockIdx.x * 8 + (tid_ >> 6), ngw = gridDim.x * 8;
    for (int row = gw; row < MR; row += ngw) {
        f32x4 v[4];
#pragma unroll
        for (int j = 0; j < 4; ++j) v[j] = ((const f32x4*)(xin + (size_t)row * DM))[lane + 64 * j];
        if (d) {
            f32x4 dv[4]; float ss = 0.f;
#pragma unroll
            for (int j = 0; j < 4; ++j) { const u32x2 w = ((const u32x2*)(d + (size_t)row * DM))[lane + 64 * j];
                dv[j][0] = __uint_as_float(w.x << 16); dv[j][1] = __uint_as_float(w.x & 0xffff0000u); dv[j][2] = __uint_as_float(w.y << 16); dv[j][3] = __uint_as_float(w.y & 0xffff0000u);
                ss += dv[j][0] * dv[j][0] + dv[j][1] * dv[j][1] + dv[j][2] * dv[j][2] + dv[j][3] * dv[j][3]; }
            const float rs = coef * rsqrtf(wave_sum(ss) * (1.f / DM) + RMS_EPS);
#pragma unroll
            for (int j = 0; j < 4; ++j) { const f32x4 g = ((const f32x4*)gA)[lane + 64 * j]; v[j] += dv[j] * g * rs; }
        }
#pragma unroll
        for (int j = 0; j < 4; ++j) ((f32x4*)(xout + (size_t)row * DM))[lane + 64 * j] = v[j];
        if (xb) {
            float ss = 0.f;
#pragma unroll
            for (int j = 0; j < 4; ++j) ss += v[j][0] * v[j][0] + v[j][1] * v[j][1] + v[j][2] * v[j][2] + v[j][3] * v[j][3];
            const float rs = rsqrtf(wave_sum(ss) * (1.f / DM) + RMS_EPS);
#pragma unroll
            for (int j = 0; j < 4; ++j) { const f32x4 g = ((const f32x4*)gB)[lane + 64 * j]; const f32x4 o = v[j] * g * rs;
                u32x2 w; w.x = pk2(o[0], o[1]); w.y = pk2(o[2], o[3]); ((u32x2*)(xb + (size_t)row * DM))[lane + 64 * j] = w; }
        }
    }
}
DEV f32x4 mm16(const float* A, int ars, int aks, const float* B, int bks, int bjs, int k_lo, int k_hi, f32x4 acc, int lane) {
    const int i = lane & 15, kq = lane >> 4;
    const float* ap = A + i * ars + kq * aks; const float* bp = B + kq * bks + i * bjs;
    for (int k0 = k_lo; k0 < k_hi; k0 += 4) acc = __builtin_amdgcn_mfma_f32_16x16x4f32(ap[k0 * aks], bp[k0 * bks], acc, 0, 0, 0);
    return acc;
}

constexpr int L_Q = 0, L_K = L_Q + 128 * 68, L_V = L_K + 128 * 68, L_S = L_V + 128 * 72, L_ST = L_S + 64 * 132, L_VEC = L_ST + 64 * 72, L_END = L_VEC + 9 * 128 + 64;
static_assert(L_END * 4 <= LDS_BYTES, "lds");
struct MixCtx { const bf16_t* z; const float* rope; float lg0, lg1, ib0, ib1, fb0, fb1; int mode; int b, h, c; };

DEV void mix_load_qkv(const MixCtx& m, float* lds, bool need_q) {
    const int tid = otid(), tok = tid >> 2, oct = tid & 3, t = m.c * CH + tok; const size_t row = (size_t)m.b * SEQ + t;
    const bf16_t* zr = m.z + row * ZLD + (m.mode == 0 ? 768 : 2752) + m.h * 64;
    float q1[8], q2[8], k1[8], k2[8], v1[8], v2[8];
    unpack8(*(const u32x4*)(zr + 256 + oct * 8), k1); unpack8(*(const u32x4*)(zr + 256 + 32 + oct * 8), k2);
    unpack8(*(const u32x4*)(zr + 512 + oct * 8), v1); unpack8(*(const u32x4*)(zr + 512 + 32 + oct * 8), v2);
    if (need_q) { unpack8(*(const u32x4*)(zr + oct * 8), q1); unpack8(*(const u32x4*)(zr + 32 + oct * 8), q2); }
    float* qs = lds + L_Q + tok * 68; float* ks = lds + L_K + tok * 68; float* vs = lds + L_V + tok * 72;
    if (m.mode == 0) {
        const float* cs = m.rope + (size_t)t * 32 + oct * 8; const float* sn = cs + SEQ * 32;
#pragma unroll
        for (int e = 0; e < 8; ++e) { const float c = cs[e], s = sn[e];
            const float ka = k1[e] * c - k2[e] * s, kb = k1[e] * s + k2[e] * c; ks[oct * 8 + e] = ka; ks[32 + oct * 8 + e] = kb;
            if (need_q) { const float qa = (q1[e] * c - q2[e] * s) * 0.125f, qb = (q1[e] * s + q2[e] * c) * 0.125f; qs[oct * 8 + e] = qa; qs[32 + oct * 8 + e] = qb; } }
    } else {
#pragma unroll
        for (int e = 0; e < 8; ++e) { ks[oct * 8 + e] = k1[e]; ks[32 + oct * 8 + e] = k2[e];
            if (need_q) { qs[oct * 8 + e] = q1[e] * 0.125f; qs[32 + oct * 8 + e] = q2[e] * 0.125f; } }
    }
#pragma unroll
    for (int e = 0; e < 8; ++e) { vs[oct * 8 + e] = v1[e]; vs[32 + oct * 8 + e] = v2[e]; }
}
DEV void mix_vectors(const MixCtx& m, float* lds, int d, float m_prev) {
    float* V = lds + L_VEC; const int tid = otid();
    if (m.mode == 0) {
        if (tid < 128) { const float lg = d == 0 ? m.lg0 : m.lg1;
            V[0 * 128 + tid] = d == 0 ? __expf((tid + 1) * lg) : __expf((128 - tid) * lg);
            V[1 * 128 + tid] = d == 0 ? __expf((127 - tid) * lg) : __expf(tid * lg); }
        __syncthreads();
        return;
    }
    if (tid < 128) { const size_t row = (size_t)m.b * SEQ + m.c * CH + tid; const bf16_t* zr = m.z + row * ZLD;
        const float li = bf2f(zr[3776 + d * 4 + m.h]) + (d == 0 ? m.ib0 : m.ib1); const float xf = bf2f(zr[3784 + d * 4 + m.h]) + (d == 0 ? m.fb0 : m.fb1);
        V[6 * 128 + tid] = li; V[7 * 128 + tid] = fminf(xf, 0.f) - log1pf(__expf(-fabsf(xf))); }
    __syncthreads();
    if (tid < 64) {
        const int s0 = d == 0 ? 2 * tid : 127 - 2 * tid, s1 = d == 0 ? 2 * tid + 1 : 126 - 2 * tid;
        const float lf0 = V[7 * 128 + s0], lf1 = V[7 * 128 + s1]; const float pair = lf0 + lf1; float incl = pair;
#pragma unroll
        for (int off = 1; off < 64; off <<= 1) { const float t = __shfl_up(incl, off); if (tid >= off) incl += t; }
        const float b0 = incl - pair + lf0, b1 = b0 + lf1;
        const float g0 = V[6 * 128 + s0] - b0, g1 = V[6 * 128 + s1] - b1;
        float inclm = fmaxf(g0, g1);
#pragma unroll
        for (int off = 1; off < 64; off <<= 1) { const float t = __shfl_up(inclm, off); if (tid >= off) inclm = fmaxf(inclm, t); }
        float exclm = __shfl_up(inclm, 1); if (tid == 0) exclm = -3.0e38f;
        const float gm0 = fmaxf(exclm, g0), gm1 = fmaxf(gm0, g1);
        V[7 * 128 + s0] = b0; V[7 * 128 + s1] = b1; V[2 * 128 + s0] = g0; V[2 * 128 + s1] = g1; V[3 * 128 + s0] = gm0; V[3 * 128 + s1] = gm1;
        if (tid == 63) { V[8 * 128 + 0] = b1; V[8 * 128 + 1] = gm1; }
    }
    __syncthreads();
    if (tid < 128) { const float gmax_t = V[3 * 128 + tid], Mt = fmaxf(m_prev, gmax_t), bt = V[7 * 128 + tid];
        const float gend = V[8 * 128 + 1];
        V[0 * 128 + tid] = __expf(m_prev - Mt); V[4 * 128 + tid] = __expf(-(bt + Mt)); V[1 * 128 + tid] = __expf(V[2 * 128 + tid] - gend);
        V[3 * 128 + tid] = Mt; }
    __syncthreads();
}
DEV void mix_passA(const MixCtx& m, float* lds, float* states, float* nst, float* sst) {
    const int tid = otid(), lane = tid & 63, wave = __builtin_amdgcn_readfirstlane(tid >> 6);
    mix_load_qkv(m, lds, false);
    __syncthreads();
    for (int d = 0; d < 2; ++d) {
        mix_vectors(m, lds, d, 0.f);
        const float* wst = lds + L_VEC + 128; const float* ks = lds + L_K; const float* vs = lds + L_V;
        const size_t slot = ((size_t)((m.b * NH + m.h) * 2 + d)) * NCH + m.c;
        float* st = states + slot * 4096;
#pragma unroll
        for (int q = 0; q < 2; ++q) { const int id = wave + 8 * q, rt = id >> 2, ct = id & 3; const int i = lane & 15, kq = lane >> 4;
            f32x4 acc = {0.f, 0.f, 0.f, 0.f};
            for (int k0 = 0; k0 < 128; k0 += 4) { const int s = k0 + kq; acc = __builtin_amdgcn_mfma_f32_16x16x4f32(ks[s * 68 + 16 * rt + i] * wst[s], vs[s * 72 + 16 * ct + i], acc, 0, 0, 0); }
#pragma unroll
            for (int r = 0; r < 4; ++r) st[(16 * rt + kq * 4 + r) * 64 + 16 * ct + i] = acc[r]; }
        if (m.mode == 1) {
            if (tid < 64) { float a = 0.f; for (int s = 0; s < 128; ++s) a += wst[s] * ks[s * 68 + tid]; nst[slot * 64 + tid] = a; }
            if (tid == 64) { const float* V = lds + L_VEC; sst[slot] = V[8 * 128 + 0]; sst[4096 + slot] = V[8 * 128 + 0] + V[8 * 128 + 1]; }
        }
        __syncthreads();
    }
}
DEV void mix_passC(const MixCtx& m, float* lds, const float* states, const float* nst, const float* sst, bf16_t* Y, const float* norm_w) {
    const int tid = otid(), lane = tid & 63, wave = __builtin_amdgcn_readfirstlane(tid >> 6), i16 = lane & 15, kq = lane >> 4;
    f32x4 oacc[4];
#pragma unroll
    for (int a = 0; a < 4; ++a) oacc[a] = (f32x4){0.f, 0.f, 0.f, 0.f};
    mix_load_qkv(m, lds, true);
    __syncthreads();
    float* V = lds + L_VEC; float* qs = lds + L_Q; float* ks = lds + L_K; float* vs = lds + L_V; float* Sh = lds + L_S; float* St = lds + L_ST;
    for (int d = 0; d < 2; ++d) {
        const size_t slot = ((size_t)((m.b * NH + m.h) * 2 + d)) * NCH + m.c;
        const float m_prev = m.mode == 1 ? sst[8192 + slot] : 0.f;
        { const float* st = states + slot * 4096;
#pragma unroll
          for (int e = 0; e < 8; ++e) { const int idx = e * 512 + tid; St[(idx >> 6) * 72 + (idx & 63)] = st[idx]; }
          if (m.mode == 1 && tid < 64) V[9 * 128 + tid] = nst[slot * 64 + tid]; }
        mix_vectors(m, lds, d, m_prev);
        const float lg = d == 0 ? m.lg0 : m.lg1;
        for (int hf = 0; hf < 2; ++hf) {
#pragma unroll
            for (int q = 0; q < 4; ++q) { const int id = wave + 8 * q, rt = id >> 3, ct = id & 7; const int tr = 64 * hf + 16 * rt, sc = 16 * ct;
                const bool masked = d == 0 ? (sc > tr + 15) : (sc + 15 < tr);
                f32x4 acc = {0.f, 0.f, 0.f, 0.f};
                if (!masked) {
                    acc = mm16(qs + tr * 68, 68, 1, ks + sc * 68, 1, 68, 0, 64, acc, lane);
                    const int s = sc + i16;
#pragma unroll
                    for (int r = 0; r < 4; ++r) { const int t = tr + kq * 4 + r; float w;
                        if (m.mode == 0) { w = d == 0 ? (s <= t ? __expf((float)(t - s) * lg) : 0.f) : (s > t ? __expf((float)(s - t) * lg) : 0.f); }
                        else { const bool ok = d == 0 ? (s <= t) : (s >= t); w = ok ? __expf(V[2 * 128 + s] - V[3 * 128 + t]) : 0.f; }
                        acc[r] *= w; } }
#pragma unroll
                for (int r = 0; r < 4; ++r) Sh[(16 * rt + kq * 4 + r) * 132 + sc + i16] = acc[r]; }
            __syncthreads();
            if (m.mode == 1) { const int row = tid >> 3, seg = tid & 7, t = 64 * hf + row; float a = 0.f;
#pragma unroll
                for (int e = 0; e < 16; ++e) a += Sh[row * 132 + seg * 16 + e];
                float qn = 0.f;
#pragma unroll
                for (int e = 0; e < 8; ++e) qn += qs[t * 68 + seg * 8 + e] * V[9 * 128 + seg * 8 + e];
                a += V[0 * 128 + t] * qn;
                a += __shfl_xor(a, 1); a += __shfl_xor(a, 2); a += __shfl_xor(a, 4);
                if (seg == 0) V[5 * 128 + t] = a;
                __syncthreads(); }
#pragma unroll
            for (int q = 0; q < 2; ++q) { const int id = wave + 8 * q, rt = id >> 2, ct = id & 3; const int tr = 64 * hf + 16 * rt;
                const int k_lo = d == 0 ? 0 : tr, k_hi = d == 0 ? tr + 16 : 128;
                f32x4 intra = {0.f, 0.f, 0.f, 0.f}, inter = {0.f, 0.f, 0.f, 0.f};
                intra = mm16(Sh + 16 * rt * 132, 132, 1, vs + 16 * ct, 72, 1, k_lo, k_hi, intra, lane);
                inter = mm16(qs + tr * 68, 68, 1, St + 16 * ct, 72, 1, 0, 64, inter, lane);
#pragma unroll
                for (int r = 0; r < 4; ++r) { const int t = tr + kq * 4 + r; float val = intra[r] + V[0 * 128 + t] * inter[r];
                    if (m.mode == 1) val = val / fmaxf(fabsf(V[5 * 128 + t]), V[4 * 128 + t]);
                    oacc[hf * 2 + q][r] += val; } }
            __syncthreads();
        }
    }
    float* os = lds + L_S;
#pragma unroll
    for (int hf = 0; hf < 2; ++hf)
#pragma unroll
        for (int q = 0; q < 2; ++q) { const int id = wave + 8 * q, rt = id >> 2, ct = id & 3; const int tr = 64 * hf + 16 * rt;
#pragma unroll
            for (int r = 0; r < 4; ++r) os[(tr + kq * 4 + r) * 66 + 16 * ct + i16] = oacc[hf * 2 + q][r]; }
    __syncthreads();
    { const int tok = tid >> 2, qd = tid & 3; const size_t row = (size_t)m.b * SEQ + m.c * CH + tok; float o[16]; float ss = 0.f;
#pragma unroll
      for (int e = 0; e < 16; ++e) { o[e] = os[tok * 66 + qd * 16 + e]; ss += o[e] * o[e]; }
      ss += __shfl_xor(ss, 1); ss += __shfl_xor(ss, 2);
      const float rs = rsqrtf(ss * (1.f / 64.f) + RMS_EPS);
      const bf16_t* zg = m.z + row * ZLD + (m.mode == 0 ? 1536 : 3520) + m.h * 64 + qd * 16;
      float g[16]; unpack8(*(const u32x4*)zg, g); unpack8(*(const u32x4*)(zg + 8), g + 8);
      float y[16];
#pragma unroll
      for (int e = 0; e < 16; ++e) { const float gate = m.mode == 0 ? g[e] * sigmoid_f(g[e]) : sigmoid_f(g[e]) * norm_w[m.h * 64 + qd * 16 + e]; y[e] = o[e] * rs * gate; }
      u32x4 w0, w1; w0.x = pk2(y[0], y[1]); w0.y = pk2(y[2], y[3]); w0.z = pk2(y[4], y[5]); w0.w = pk2(y[6], y[7]);
      w1.x = pk2(y[8], y[9]); w1.y = pk2(y[10], y[11]); w1.z = pk2(y[12], y[13]); w1.w = pk2(y[14], y[15]);
      bf16_t* yp = Y + row * DM + (m.mode == 0 ? 256 : 768) + m.h * 64 + qd * 16;
      *(u32x4*)yp = w0; *(u32x4*)(yp + 8) = w1; }
    __syncthreads();
}

DEV void mix_passB(PP p, int l, float* lds) {
    float* rs = (float*)(p->ws + WS_RET); float* mc = (float*)(p->ws + WS_MLC); float* mn = (float*)(p->ws + WS_MLN); float* ms = (float*)(p->ws + WS_MLS);
    const float* dl = p->in[9] + l * 8; const int tid = otid();
    const int G = gridDim.x; const int first = G > 64 ? 32 : 0, nW = G - first, w = (int)blockIdx.x - first;
    if (w < 0) return;
    float* so_l = lds; float* sn_l = lds + 64;
    for (int item = w; item < 256; item += nW) {
        const int seq = item >> 3, el = ((item & 7) << 9) + tid, d = seq & 1, h = (seq >> 1) & 3;
        __syncthreads();
        if (tid == 0) { float mm = 0.f;
            for (int i = 0; i < NCH; ++i) { const int c = d ? NCH - 1 - i : i; const int slot = seq * NCH + c; const float bend = ms[slot], mloc = ms[4096 + slot];
                const float mnew = fmaxf(bend + mm, mloc); so_l[c] = __expf(bend + mm - mnew); sn_l[c] = __expf(mloc - mnew); if ((item & 7) == 0) ms[8192 + slot] = mm; mm = mnew; } }
        {
            const float x = dl[d * 4 + h]; const float lg = fminf(x, 0.f) - log1pf(__expf(-fabsf(x))); const float dec = __expf(128.f * lg);
            float* base = rs + (size_t)seq * NCH * 4096 + el; float F = 0.f;
#pragma unroll 1
            for (int bt = 0; bt < 4; ++bt) { float v[16]; float* bb = base + (size_t)(d ? 3 - bt : bt) * 16 * 4096;
#pragma unroll
                for (int i = 0; i < 16; ++i) v[i] = bb[(size_t)i * 4096];
                if (d == 0) {
#pragma unroll
                    for (int i = 0; i < 16; ++i) { const float t = v[i]; v[i] = F; F = dec * F + t; }
                } else {
#pragma unroll
                    for (int i = 15; i >= 0; --i) { const float t = v[i]; v[i] = F; F = dec * F + t; }
                }
#pragma unroll
                for (int i = 0; i < 16; ++i) bb[(size_t)i * 4096] = v[i]; }
        }
        __syncthreads();
        {
            float* base = mc + (size_t)seq * NCH * 4096 + el; float C = 0.f;
#pragma unroll 1
            for (int bt = 0; bt < 4; ++bt) { float v[16]; const int c0 = (d ? 3 - bt : bt) * 16; float* bb = base + (size_t)c0 * 4096;
#pragma unroll
                for (int i = 0; i < 16; ++i) v[i] = bb[(size_t)i * 4096];
                if (d == 0) {
#pragma unroll
                    for (int i = 0; i < 16; ++i) { const float t = v[i]; v[i] = C; C = so_l[c0 + i] * C + sn_l[c0 + i] * t; }
                } else {
#pragma unroll
                    for (int i = 15; i >= 0; --i) { const float t = v[i]; v[i] = C; C = so_l[c0 + i] * C + sn_l[c0 + i] * t; }
                }
#pragma unroll
                for (int i = 0; i < 16; ++i) bb[(size_t)i * 4096] = v[i]; }
        }
        if ((item & 7) == 0 && tid < 64) {
            float* nb = mn + (size_t)seq * NCH * 64 + tid; float nn = 0.f;
            for (int i = 0; i < NCH; ++i) { const int c = d ? NCH - 1 - i : i; const float nl = nb[(size_t)c * 64]; nb[(size_t)c * 64] = nn; nn = so_l[c] * nn + sn_l[c] * nl; }
        }
    }
}
DEV void conv_mixer(PP p, int l, const bf16_t* z, bf16_t* Y) {
    const float* cw = p->in[7] + l * 768; const float* cb = p->in[8] + l * 256;
    const int gt = blockIdx.x * 512 + otid(), ngt = gridDim.x * 512;
    for (int it = gt; it < MR * 32; it += ngt) {
        const int row = it >> 5, c8 = (it & 31) * 8, t = row & (SEQ - 1); const bf16_t* zr = z + (size_t)row * ZLD;
        float gb[8], a[8], b[8], up[8], un[8], u[8];
        unpack8(*(const u32x4*)(zr + c8), gb); unpack8(*(const u32x4*)(zr + 256 + c8), a); unpack8(*(const u32x4*)(zr + 512 + c8), b);
#pragma unroll
        for (int e = 0; e < 8; ++e) { u[e] = a[e] * b[e]; up[e] = 0.f; un[e] = 0.f; }
        if (t > 0) { unpack8(*(const u32x4*)(zr - ZLD + 256 + c8), a); unpack8(*(const u32x4*)(zr - ZLD + 512 + c8), b);
#pragma unroll
            for (int e = 0; e < 8; ++e) up[e] = a[e] * b[e]; }
        if (t < SEQ - 1) { unpack8(*(const u32x4*)(zr + ZLD + 256 + c8), a); unpack8(*(const u32x4*)(zr + ZLD + 512 + c8), b);
#pragma unroll
            for (int e = 0; e < 8; ++e) un[e] = a[e] * b[e]; }
        float y[8];
#pragma unroll
        for (int e = 0; e < 8; ++e) y[e] = gb[e] * (up[e] * cw[c8 + e] + u[e] * cw[256 + c8 + e] + un[e] * cw[512 + c8 + e] + cb[c8 + e]);
        u32x4 w; w.x = pk2(y[0], y[1]); w.y = pk2(y[2], y[3]); w.z = pk2(y[4], y[5]); w.w = pk2(y[6], y[7]);
        *(u32x4*)(Y + (size_t)row * DM + c8) = w;
    }
}

DEV float rw_shift(const bf16_t* z, size_t row, int t, int col, const float* mu) {
    const bf16_t* zr = z + row * ZLD + 1792 + col; const float x = bf2f(zr[0]);
    const float pv = t > 0 ? bf2f(zr[-ZLD]) : 0.f, nx = t < SEQ - 1 ? bf2f(zr[ZLD]) : 0.f;
    return x + mu[col] * (0.5f * (pv + nx) - x);
}
struct RwCtx { const bf16_t* z; const float *mu, *w0, *w2, *a0, *a2, *k_k, *k_a, *r_k; float* sbon; int b, c, d; };
DEV void rw_load_raw(const RwCtx& R, int sb, int ch, int lc, float (&raw)[40]) {
    const int sgn = R.d == 0 ? 1 : -1; const int first = R.c * RW_LC + (R.d == 0 ? sb * RW_T : RW_LC - 1 - sb * RW_T);
#pragma unroll
    for (int q = 0; q < 10; ++q) { const int t = first + sgn * (q - 1); const bool ok = (t >= 0) && (t < SEQ);
        const bf16_t* zr = R.z + ((size_t)R.b * SEQ + (ok ? t : 0)) * ZLD + 1792;
        raw[q * 4 + 0] = ok ? bf2f(zr[ch]) : 0.f; raw[q * 4 + 1] = ok ? bf2f(zr[256 + ch]) : 0.f; raw[q * 4 + 2] = ok ? bf2f(zr[512 + ch]) : 0.f; raw[q * 4 + 3] = ok ? bf2f(zr[lc]) : 0.f; }
}
struct RwConst { float mur, muk, muv, mul, w0v, a0v, kkw, kaw, rkw; };
template <int PASS> DEV void rw_prep(const RwCtx& R, const RwConst& K, float* ops, float* latw, int sb, int bi, int hp, int lane, const float (&w2r)[32], const float (&a2r)[32], const float (&raw)[40]) {
    const int d = R.d;
    float* obase = ops + ((bi * 4 + hp) * RW_T) * 384;
    float kx[RW_T], rx[RW_T];
#pragma unroll
    for (int j = 0; j < RW_T; ++j) {
        const float* c = raw + (j + 1) * 4; const float* pv = raw + j * 4; const float* nx = raw + (j + 2) * 4;
        rx[j] = c[0] + K.mur * (0.5f * (pv[0] + nx[0]) - c[0]); kx[j] = c[1] + K.muk * (0.5f * (pv[1] + nx[1]) - c[1]);
        const float vv = c[2] + K.muv * (0.5f * (pv[2] + nx[2]) - c[2]); float lv = c[3] + K.mul * (0.5f * (pv[3] + nx[3]) - c[3]);
        if (lane < 32) lv = tanh_f(lv);
        float* o = obase + j * 384;
        latw[j * 64 + lane] = lv; o[256 + lane] = rx[j]; o[320 + lane] = vv; }
    asm volatile("s_waitcnt lgkmcnt(0)" ::: "memory");
#pragma unroll
    for (int j = 0; j < RW_T; ++j) {
        float accw = 0.f, acca = 0.f;
#pragma unroll
        for (int r4 = 0; r4 < 8; ++r4) { const f32x4 lw = *(const f32x4*)(latw + j * 64 + 4 * r4), la = *(const f32x4*)(latw + j * 64 + 32 + 4 * r4);
            accw += lw[0] * w2r[4 * r4] + lw[1] * w2r[4 * r4 + 1] + lw[2] * w2r[4 * r4 + 2] + lw[3] * w2r[4 * r4 + 3];
            acca += la[0] * a2r[4 * r4] + la[1] * a2r[4 * r4 + 1] + la[2] * a2r[4 * r4 + 2] + la[3] * a2r[4 * r4 + 3]; }
        float* o = obase + j * 384;
        const float wlog = -softplus_f(-(K.w0v + accw)) - 0.5f; const float decay = __expf(-__expf(wlog));
        const float a = sigmoid_f(K.a0v + acca);
        const float kkv = kx[j] * K.kkw; const float ss = wave_sum(kkv * kkv); const float kkn = kkv / fmaxf(sqrtf(ss), 1e-12f);
        const float kd = kx[j] * (1.f + (a - 1.f) * K.kaw);
        o[lane] = decay; o[64 + lane] = kkn * a; o[128 + lane] = kd; o[192 + lane] = -kkn;
        if (PASS == 2) { const float sbv = wave_sum(rx[j] * kd * K.rkw);
            const int jj = d == 0 ? sb * RW_T + j : RW_LC - 1 - (sb * RW_T + j); const size_t row = (size_t)R.b * SEQ + R.c * RW_LC + jj;
            if (lane == 0) R.sbon[((size_t)d * MR + row) * 4 + hp] = sbv; }
    }
}
template <int PASS> DEV void rw_task(PP p, int l, int task, float* lds) {
    const int tid = otid(), wave = __builtin_amdgcn_readfirstlane(tid >> 6), lane = tid & 63;
    RwCtx R; R.z = (const bf16_t*)(p->ws + WS_BIG); R.mu = p->in[10] + l * 960; R.w0 = p->in[11] + l * 512; R.w2 = p->in[12] + l * 16384; R.a0 = p->in[13] + l * 512; R.a2 = p->in[14] + l * 16384;
    R.k_k = p->in[16] + l * 256; R.k_a = p->in[17] + l * 256; R.r_k = p->in[18] + l * 256; R.sbon = (float*)(p->ws + WS_SBON);
    R.d = task & 1; R.c = (task >> 1) & (RW_NC - 1); R.b = task >> 6;
    float* ops = lds; float* latw = lds + 2 * 4 * RW_T * 384 + (wave & 3) * RW_T * 64;
    float* pe = (float*)(p->ws + WS_PE); float* wkv = (float*)(p->ws + WS_WKV);
    const int h = wave & 3; const int chain = (R.b * NH + h) * 2 + R.d; const int sc = R.d == 0 ? R.c : RW_NC - 1 - R.c;
    float* slot = pe + ((size_t)chain * RW_NC + sc) * 8192;
    if (wave >= 4) {
        const int hp = wave - 4, ch = hp * 64 + lane; const int lc = lane < 32 ? 768 + R.d * 32 + lane : 832 + R.d * 32 + (lane - 32);
        float w2r[32], a2r[32];
#pragma unroll
        for (int r = 0; r < 32; ++r) { w2r[r] = R.w2[(R.d * 32 + r) * 256 + ch]; a2r[r] = R.a2[(R.d * 32 + r) * 256 + ch]; }
        RwConst K; K.mur = R.mu[ch]; K.muk = R.mu[256 + ch]; K.muv = R.mu[512 + ch]; K.mul = R.mu[lc];
        K.w0v = R.w0[R.d * 256 + ch]; K.a0v = R.a0[R.d * 256 + ch]; K.kkw = R.k_k[ch]; K.kaw = R.k_a[ch]; K.rkw = R.r_k[ch];
        float raw[40], nxt[40];
        rw_load_raw(R, 0, ch, lc, raw);
        rw_load_raw(R, 1, ch, lc, nxt);
        rw_prep<PASS>(R, K, ops, latw, 0, 0, hp, lane, w2r, a2r, raw);
        __syncthreads();
#pragma unroll 1
        for (int sb = 0; sb < RW_LC / RW_T; ++sb) {
            if (sb + 1 < RW_LC / RW_T) {
#pragma unroll
                for (int e = 0; e < 40; ++e) raw[e] = nxt[e];
                if (sb + 2 < RW_LC / RW_T) rw_load_raw(R, sb + 2, ch, lc, nxt);
                rw_prep<PASS>(R, K, ops, latw, sb + 1, (sb + 1) & 1, hp, lane, w2r, a2r, raw); }
            __syncthreads();
        }
        return;
    }
    f32x2 S[32], P[32];
    if (PASS == 1) {
#pragma unroll
        for (int k = 0; k < 32; ++k) { S[k] = (f32x2){0.f, 0.f}; P[k] = (f32x2){(2 * k == lane) ? 1.f : 0.f, (2 * k + 1 == lane) ? 1.f : 0.f}; }
    } else {
#pragma unroll
        for (int k = 0; k < 16; ++k) { const f32x4 v = *(const f32x4*)(slot + 4096 + lane * 64 + 4 * k); S[2 * k] = (f32x2){v[0], v[1]}; S[2 * k + 1] = (f32x2){v[2], v[3]};
            P[2 * k] = (f32x2){0.f, 0.f}; P[2 * k + 1] = (f32x2){0.f, 0.f}; }
    }
    __syncthreads();
    const unsigned ldsb = (unsigned)(uintptr_t)(__attribute__((address_space(3))) float*)ops;
#pragma unroll 1
    for (int sb = 0; sb < RW_LC / RW_T; ++sb) {
        const unsigned obase = ldsb + (unsigned)((((sb & 1) * 4 + h) * RW_T) * 384) * 4u;
        f32x4 nk[8]; f32x4 ub[4][4];
        asm volatile("ds_read_b128 %0, %1 offset:768" : "=v"(nk[0]) : "v"(obase) : "memory");
        asm volatile("ds_read_b128 %0, %1 offset:784" : "=v"(nk[1]) : "v"(obase) : "memory");
        asm volatile("ds_read_b128 %0, %1 offset:800" : "=v"(nk[2]) : "v"(obase) : "memory");
        asm volatile("ds_read_b128 %0, %1 offset:816" : "=v"(nk[3]) : "v"(obase) : "memory");
        asm volatile("ds_read_b128 %0, %1 offset:832" : "=v"(nk[4]) : "v"(obase) : "memory");
        asm volatile("ds_read_b128 %0, %1 offset:848" : "=v"(nk[5]) : "v"(obase) : "memory");
        asm volatile("ds_read_b128 %0, %1 offset:864" : "=v"(nk[6]) : "v"(obase) : "memory");
        asm volatile("ds_read_b128 %0, %1 offset:880" : "=v"(nk[7]) : "v"(obase) : "memory");
#pragma unroll 1
        for (int j = 0; j < RW_T; ++j) {
            const unsigned oaddr = obase + (unsigned)j * 1536u; const unsigned naddr = (j + 1 < RW_T) ? oaddr + 1536u : oaddr, vaddr = oaddr + 4u * (unsigned)lane;
            if constexpr (PASS == 1) {
            f32x2 sa2 = {0.f, 0.f}, sp2 = {0.f, 0.f}; float vvn;
            asm volatile("ds_read_b32 %0, %1 offset:1280" : "=v"(vvn) : "v"(vaddr) : "memory");
            asm volatile("s_waitcnt lgkmcnt(8)" : "+v"(nk[0]) :: "memory");
            { const f32x2 n0 = {nk[0][0], nk[0][1]}, n1 = {nk[0][2], nk[0][3]}; sa2 += S[0] * n0; sa2 += S[1] * n1; sp2 += P[0] * n0; sp2 += P[1] * n1; }
            asm volatile("" : "+v"(sa2), "+v"(sp2) : "v"(nk[0]));
            asm volatile("ds_read_b128 %0, %1 offset:896" : "=v"(nk[0]) : "v"(oaddr) : "memory");
            asm volatile("s_waitcnt lgkmcnt(8)" : "+v"(nk[1]) :: "memory");
            { const f32x2 n0 = {nk[1][0], nk[1][1]}, n1 = {nk[1][2], nk[1][3]}; sa2 += S[2] * n0; sa2 += S[3] * n1; sp2 += P[2] * n0; sp2 += P[3] * n1; }
            asm volatile("" : "+v"(sa2), "+v"(sp2) : "v"(nk[1]));
            asm volatile("ds_read_b128 %0, %1 offset:912" : "=v"(nk[1]) : "v"(oaddr) : "memory");
            asm volatile("s_waitcnt lgkmcnt(8)" : "+v"(nk[2]) :: "memory");
            { const f32x2 n0 = {nk[2][0], nk[2][1]}, n1 = {nk[2][2], nk[2][3]}; sa2 += S[4] * n0; sa2 += S[5] * n1; sp2 += P[4] * n0; sp2 += P[5] * n1; }
            asm volatile("" : "+v"(sa2), "+v"(sp2) : "v"(nk[2]));
            asm volatile("ds_read_b128 %0, %1 offset:928" : "=v"(nk[2]) : "v"(oaddr) : "memory");
            asm volatile("s_waitcnt lgkmcnt(8)" : "+v"(nk[3]) :: "memory");
            { const f32x2 n0 = {nk[3][0], nk[3][1]}, n1 = {nk[3][2], nk[3][3]}; sa2 += S[6] * n0; sa2 += S[7] * n1; sp2 += P[6] * n0; sp2 += P[7] * n1; }
            asm volatile("" : "+v"(sa2), "+v"(sp2) : "v"(nk[3]));
            asm volatile("ds_read_b128 %0, %1 offset:944" : "=v"(nk[3]) : "v"(oaddr) : "memory");
            asm volatile("s_waitcnt lgkmcnt(8)" : "+v"(nk[4]) :: "memory");
            { const f32x2 n0 = {nk[4][0], nk[4][1]}, n1 = {nk[4][2], nk[4][3]}; sa2 += S[8] * n0; sa2 += S[9] * n1; sp2 += P[8] * n0; sp2 += P[9] * n1; }
            asm volatile("" : "+v"(sa2), "+v"(sp2) : "v"(nk[4]));
            asm volatile("ds_read_b128 %0, %1 offset:960" : "=v"(nk[4]) : "v"(oaddr) : "memory");
            asm volatile("s_waitcnt lgkmcnt(8)" : "+v"(nk[5]) :: "memory");
            { const f32x2 n0 = {nk[5][0], nk[5][1]}, n1 = {nk[5][2], nk[5][3]}; sa2 += S[10] * n0; sa2 += S[11] * n1; sp2 += P[10] * n0; sp2 += P[11] * n1; }
            asm volatile("" : "+v"(sa2), "+v"(sp2) : "v"(nk[5]));
            asm volatile("ds_read_b128 %0, %1 offset:976" : "=v"(nk[5]) : "v"(oaddr) : "memory");
            asm volatile("s_waitcnt lgkmcnt(8)" : "+v"(nk[6]) :: "memory");
            { const f32x2 n0 = {nk[6][0], nk[6][1]}, n1 = {nk[6][2], nk[6][3]}; sa2 += S[12] * n0; sa2 += S[13] * n1; sp2 += P[12] * n0; sp2 += P[13] * n1; }
            asm volatile("" : "+v"(sa2), "+v"(sp2) : "v"(nk[6]));
            asm volatile("ds_read_b128 %0, %1 offset:992" : "=v"(nk[6]) : "v"(oaddr) : "memory");
            asm volatile("s_waitcnt lgkmcnt(8)" : "+v"(nk[7]) :: "memory");
            { const f32x2 n0 = {nk[7][0], nk[7][1]}, n1 = {nk[7][2], nk[7][3]}; sa2 += S[14] * n0; sa2 += S[15] * n1; sp2 += P[14] * n0; sp2 += P[15] * n1; }
            asm volatile("" : "+v"(sa2), "+v"(sp2) : "v"(nk[7]));
            asm volatile("ds_read_b128 %0, %1 offset:1008" : "=v"(nk[7]) : "v"(oaddr) : "memory");
            asm volatile("s_waitcnt lgkmcnt(7)" : "+v"(nk[0]), "+v"(vvn) :: "memory");
            const float vv = vvn;
            { const f32x2 n0 = {nk[0][0], nk[0][1]}, n1 = {nk[0][2], nk[0][3]}; sa2 += S[16] * n0; sa2 += S[17] * n1; sp2 += P[16] * n0; sp2 += P[17] * n1; }
            asm volatile("" : "+v"(sa2), "+v"(sp2) : "v"(nk[0]));
            asm volatile("s_waitcnt lgkmcnt(6)" : "+v"(nk[1]) :: "memory");
            { const f32x2 n0 = {nk[1][0], nk[1][1]}, n1 = {nk[1][2], nk[1][3]}; sa2 += S[18] * n0; sa2 += S[19] * n1; sp2 += P[18] * n0; sp2 += P[19] * n1; }
            asm volatile("" : "+v"(sa2), "+v"(sp2) : "v"(nk[1]));
            asm volatile("ds_read_b128 %0, %1 offset:0" : "=v"(ub[0][0]) : "v"(oaddr) : "memory");
            asm volatile("ds_read_b128 %0, %1 offset:256" : "=v"(ub[0][1]) : "v"(oaddr) : "memory");
            asm volatile("ds_read_b128 %0, %1 offset:512" : "=v"(ub[0][2]) : "v"(oaddr) : "memory");
            asm volatile("s_waitcnt lgkmcnt(8)" : "+v"(nk[2]) :: "memory");
            { const f32x2 n0 = {nk[2][0], nk[2][1]}, n1 = {nk[2][2], nk[2][3]}; sa2 += S[20] * n0; sa2 += S[21] * n1; sp2 += P[20] * n0; sp2 += P[21] * n1; }
            asm volatile("" : "+v"(sa2), "+v"(sp2) : "v"(nk[2]));
            asm volatile("s_waitcnt lgkmcnt(7)" : "+v"(nk[3]) :: "memory");
            { const f32x2 n0 = {nk[3][0], nk[3][1]}, n1 = {nk[3][2], nk[3][3]}; sa2 += S[22] * n0; sa2 += S[23] * n1; sp2 += P[22] * n0; sp2 += P[23] * n1; }
            asm volatile("" : "+v"(sa2), "+v"(sp2) : "v"(nk[3]));
            asm volatile("ds_read_b128 %0, %1 offset:16" : "=v"(ub[1][0]) : "v"(oaddr) : "memory");
            asm volatile("ds_read_b128 %0, %1 offset:272" : "=v"(ub[1][1]) : "v"(oaddr) : "memory");
            asm volatile("ds_read_b128 %0, %1 offset:528" : "=v"(ub[1][2]) : "v"(oaddr) : "memory");
            asm volatile("s_waitcnt lgkmcnt(9)" : "+v"(nk[4]) :: "memory");
            { const f32x2 n0 = {nk[4][0], nk[4][1]}, n1 = {nk[4][2], nk[4][3]}; sa2 += S[24] * n0; sa2 += S[25] * n1; sp2 += P[24] * n0; sp2 += P[25] * n1; }
            asm volatile("" : "+v"(sa2), "+v"(sp2) : "v"(nk[4]));
            asm volatile("s_waitcnt lgkmcnt(8)" : "+v"(nk[5]) :: "memory");
            { const f32x2 n0 = {nk[5][0], nk[5][1]}, n1 = {nk[5][2], nk[5][3]}; sa2 += S[26] * n0; sa2 += S[27] * n1; sp2 += P[26] * n0; sp2 += P[27] * n1; }
            asm volatile("" : "+v"(sa2), "+v"(sp2) : "v"(nk[5]));
            asm volatile("ds_read_b128 %0, %1 offset:32" : "=v"(ub[2][0]) : "v"(oaddr) : "memory");
            asm volatile("ds_read_b128 %0, %1 offset:288" : "=v"(ub[2][1]) : "v"(oaddr) : "memory");
            asm volatile("ds_read_b128 %0, %1 offset:544" : "=v"(ub[2][2]) : "v"(oaddr) : "memory");
            asm volatile("s_waitcnt lgkmcnt(10)" : "+v"(nk[6]) :: "memory");
            { const f32x2 n0 = {nk[6][0], nk[6][1]}, n1 = {nk[6][2], nk[6][3]}; sa2 += S[28] * n0; sa2 += S[29] * n1; sp2 += P[28] * n0; sp2 += P[29] * n1; }
            asm volatile("" : "+v"(sa2), "+v"(sp2) : "v"(nk[6]));
            asm volatile("s_waitcnt lgkmcnt(9)" : "+v"(nk[7]) :: "memory");
            { const f32x2 n0 = {nk[7][0], nk[7][1]}, n1 = {nk[7][2], nk[7][3]}; sa2 += S[30] * n0; sa2 += S[31] * n1; sp2 += P[30] * n0; sp2 += P[31] * n1; }
            asm volatile("" : "+v"(sa2), "+v"(sp2) : "v"(nk[7]));
            asm volatile("ds_read_b128 %0, %1 offset:48" : "=v"(ub[3][0]) : "v"(oaddr) : "memory");
            asm volatile("ds_read_b128 %0, %1 offset:304" : "=v"(ub[3][1]) : "v"(oaddr) : "memory");
            asm volatile("ds_read_b128 %0, %1 offset:560" : "=v"(ub[3][2]) : "v"(oaddr) : "memory");
            const float sa = sa2[0] + sa2[1], sp = sp2[0] + sp2[1]; const f32x2 sav = {sa, sa}, spv = {sp, sp}, vvv = {vv, vv}; f32x2 y2 = {0.f, 0.f}; (void)spv; (void)sp;
            asm volatile("s_waitcnt lgkmcnt(9)" : "+v"(ub[0][0]), "+v"(ub[0][1]), "+v"(ub[0][2]) :: "memory");
            { const f32x2 w0 = {ub[0][0][0], ub[0][0][1]}, b0 = {ub[0][1][0], ub[0][1][1]}, d0 = {ub[0][2][0], ub[0][2][1]}; S[0] = S[0] * w0 + sav * b0 + vvv * d0; P[0] = P[0] * w0 + spv * b0; }
            { const f32x2 w1 = {ub[0][0][2], ub[0][0][3]}, b1 = {ub[0][1][2], ub[0][1][3]}, d1 = {ub[0][2][2], ub[0][2][3]}; S[1] = S[1] * w1 + sav * b1 + vvv * d1; P[1] = P[1] * w1 + spv * b1; }
            asm volatile("" : "+v"(S[0]), "+v"(S[1]), "+v"(P[0]), "+v"(P[1]) : "v"(ub[0][0]), "v"(ub[0][1]), "v"(ub[0][2]));
            asm volatile("ds_read_b128 %0, %1 offset:64" : "=v"(ub[0][0]) : "v"(oaddr) : "memory");
            asm volatile("ds_read_b128 %0, %1 offset:320" : "=v"(ub[0][1]) : "v"(oaddr) : "memory");
            asm volatile("ds_read_b128 %0, %1 offset:576" : "=v"(ub[0][2]) : "v"(oaddr) : "memory");
            asm volatile("s_waitcnt lgkmcnt(9)" : "+v"(ub[1][0]), "+v"(ub[1][1]), "+v"(ub[1][2]) :: "memory");
            { const f32x2 w0 = {ub[1][0][0], ub[1][0][1]}, b0 = {ub[1][1][0], ub[1][1][1]}, d0 = {ub[1][2][0], ub[1][2][1]}; S[2] = S[2] * w0 + sav * b0 + vvv * d0; P[2] = P[2] * w0 + spv * b0; }
            { const f32x2 w1 = {ub[1][0][2], ub[1][0][3]}, b1 = {ub[1][1][2], ub[1][1][3]}, d1 = {ub[1][2][2], ub[1][2][3]}; S[3] = S[3] * w1 + sav * b1 + vvv * d1; P[3] = P[3] * w1 + spv * b1; }
            asm volatile("" : "+v"(S[2]), "+v"(S[3]), "+v"(P[2]), "+v"(P[3]) : "v"(ub[1][0]), "v"(ub[1][1]), "v"(ub[1][2]));
            asm volatile("ds_read_b128 %0, %1 offset:80" : "=v"(ub[1][0]) : "v"(oaddr) : "memory");
            asm volatile("ds_read_b128 %0, %1 offset:336" : "=v"(ub[1][1]) : "v"(oaddr) : "memory");
            asm volatile("ds_read_b128 %0, %1 offset:592" : "=v"(ub[1][2]) : "v"(oaddr) : "memory");
            asm volatile("s_waitcnt lgkmcnt(9)" : "+v"(ub[2][0]), "+v"(ub[2][1]), "+v"(ub[2][2]) :: "memory");
            { const f32x2 w0 = {ub[2][0][0], ub[2][0][1]}, b0 = {ub[2][1][0], ub[2][1][1]}, d0 = {ub[2][2][0], ub[2][2][1]}; S[4] = S[4] * w0 + sav * b0 + vvv * d0; P[4] = P[4] * w0 + spv * b0; }
            { const f32x2 w1 = {ub[2][0][2], ub[2][0][3]}, b1 = {ub[2][1][2], ub[2][1][3]}, d1 = {ub[2][2][2], ub[2][2][3]}; S[5] = S[5] * w1 + sav * b1 + vvv * d1; P[5] = P[5] * w1 + spv * b1; }
            asm volatile("" : "+v"(S[4]), "+v"(S[5]), "+v"(P[4]), "+v"(P[5]) : "v"(ub[2][0]), "v"(ub[2][1]), "v"(ub[2][2]));
            asm volatile("ds_read_b128 %0, %1 offset:96" : "=v"(ub[2][0]) : "v"(oaddr) : "memory");
            asm volatile("ds_read_b128 %0, %1 offset:352" : "=v"(ub[2][1]) : "v"(oaddr) : "memory");
            asm volatile("ds_read_b128 %0, %1 offset:608" : "=v"(ub[2][2]) : "v"(oaddr) : "memory");
            asm volatile("s_waitcnt lgkmcnt(9)" : "+v"(ub[3][0]), "+v"(ub[3][1]), "+v"(ub[3][2]) :: "memory");
            { const f32x2 w0 = {ub[3][0][0], ub[3][0][1]}, b0 = {ub[3][1][0], ub[3][1][1]}, d0 = {ub[3][2][0], ub[3][2][1]}; S[6] = S[6] * w0 + sav * b0 + vvv * d0; P[6] = P[6] * w0 + spv * b0; }
            { const f32x2 w1 = {ub[3][0][2], ub[3][0][3]}, b1 = {ub[3][1][2], ub[3][1][3]}, d1 = {ub[3][2][2], ub[3][2][3]}; S[7] = S[7] * w1 + sav * b1 + vvv * d1; P[7] = P[7] * w1 + spv * b1; }
            asm volatile("" : "+v"(S[6]), "+v"(S[7]), "+v"(P[6]), "+v"(P[7]) : "v"(ub[3][0]), "v"(ub[3][1]), "v"(ub[3][2]));
            asm volatile("ds_read_b128 %0, %1 offset:112" : "=v"(ub[3][0]) : "v"(oaddr) : "memory");
            asm volatile("ds_read_b128 %0, %1 offset:368" : "=v"(ub[3][1]) : "v"(oaddr) : "memory");
            asm volatile("ds_read_b128 %0, %1 offset:624" : "=v"(ub[3][2]) : "v"(oaddr) : "memory");
            asm volatile("s_waitcnt lgkmcnt(9)" : "+v"(ub[0][0]), "+v"(ub[0][1]), "+v"(ub[0][2]) :: "memory");
            { const f32x2 w0 = {ub[0][0][0], ub[0][0][1]}, b0 = {ub[0][1][0], ub[0][1][1]}, d0 = {ub[0][2][0], ub[0][2][1]}; S[8] = S[8] * w0 + sav * b0 + vvv * d0; P[8] = P[8] * w0 + spv * b0; }
            { const f32x2 w1 = {ub[0][0][2], ub[0][0][3]}, b1 = {ub[0][1][2], ub[0][1][3]}, d1 = {ub[0][2][2], ub[0][2][3]}; S[9] = S[9] * w1 + sav * b1 + vvv * d1; P[9] = P[9] * w1 + spv * b1; }
            asm volatile("" : "+v"(S[8]), "+v"(S[9]), "+v"(P[8]), "+v"(P[9]) : "v"(ub[0][0]), "v"(ub[0][1]), "v"(ub[0][2]));
            asm volatile("ds_read_b128 %0, %1 offset:128" : "=v"(ub[0][0]) : "v"(oaddr) : "memory");
            asm volatile("ds_read_b128 %0, %1 offset:384" : "=v"(ub[0][1]) : "v"(oaddr) : "memory");
            asm volatile("ds_read_b128 %0, %1 offset:640" : "=v"(ub[0][2]) : "v"(oaddr) : "memory");
            asm volatile("s_waitcnt lgkmcnt(9)" : "+v"(ub[1][0]), "+v"(ub[1][1]), "+v"(ub[1][2]) :: "memory");
            { const f32x2 w0 = {ub[1][0][0], ub[1][0][1]}, b0 = {ub[1][1][0], ub[1][1][1]}, d0 = {ub[1][2][0], ub[1][2][1]}; S[10] = S[10] * w0 + sav * b0 + vvv * d0; P[10] = P[10] * w0 + spv * b0; }
            { const f32x2 w1 = {ub[1][0][2], ub[1][0][3]}, b1 = {ub[1][1][2], ub[1][1][3]}, d1 = {ub[1][2][2], ub[1][2][3]}; S[11] = S[11] * w1 + sav * b1 + vvv * d1; P[11] = P[11] * w1 + spv * b1; }
            asm volatile("" : "+v"(S[10]), "+v"(S[11]), "+v"(P[10]), "+v"(P[11]) : "v"(ub[1][0]), "v"(ub[1][1]), "v"(ub[1][2]));
            asm volatile("ds_read_b128 %0, %1 offset:144" : "=v"(ub[1][0]) : "v"(oaddr) : "memory");
            asm volatile("ds_read_b128 %0, %1 offset:400" : "=v"(ub[1][1]) : "v"(oaddr) : "memory");
            asm volatile("ds_read_b128 %0, %1 offset:656" : "=v"(ub[1][2]) : "v"(oaddr) : "memory");
            asm volatile("s_waitcnt lgkmcnt(9)" : "+v"(ub[2][0]), "+v"(ub[2][1]), "+v"(ub[2][2]) :: "memory");
            { const f32x2 w0 = {ub[2][0][0], ub[2][0][1]}, b0 = {ub[2][1][0], ub[2][1][1]}, d0 = {ub[2][2][0], ub[2][2][1]}; S[12] = S[12] * w0 + sav * b0 + vvv * d0; P[12] = P[12] * w0 + spv * b0; }
            { const f32x2 w1 = {ub[2][0][2], ub[2][0][3]}, b1 = {ub[2][1][2], ub[2][1][3]}, d1 = {ub[2][2][2], ub[2][2][3]}; S[13] = S[13] * w1 + sav * b1 + vvv * d1; P[13] = P[13] * w1 + spv * b1; }
            asm volatile("" : "+v"(S[12]), "+v"(S[13]), "+v"(P[12]), "+v"(P[13]) : "v"(ub[2][0]), "v"(ub[2][1]), "v"(ub[2][2]));
            asm volatile("ds_read_b128 %0, %1 offset:160" : "=v"(ub[2][0]) : "v"(oaddr) : "memory");
            asm volatile("ds_read_b128 %0, %1 offset:416" : "=v"(ub[2][1]) : "v"(oaddr) : "memory");
            asm volatile("ds_read_b128 %0, %1 offset:672" : "=v"(ub[2][2]) : "v"(oaddr) : "memory");
            asm volatile("s_waitcnt lgkmcnt(9)" : "+v"(ub[3][0]), "+v"(ub[3][1]), "+v"(ub[3][2]) :: "memory");
            { const f32x2 w0 = {ub[3][0][0], ub[3][0][1]}, b0 = {ub[3][1][0], ub[3][1][1]}, d0 = {ub[3][2][0], ub[3][2][1]}; S[14] = S[14] * w0 + sav * b0 + vvv * d0; P[14] = P[14] * w0 + spv * b0; }
            { const f32x2 w1 = {ub[3][0][2], ub[3][0][3]}, b1 = {ub[3][1][2], ub[3][1][3]}, d1 = {ub[3][2][2], ub[3][2][3]}; S[15] = S[15] * w1 + sav * b1 + vvv * d1; P[15] = P[15] * w1 + spv * b1; }
            asm volatile("" : "+v"(S[14]), "+v"(S[15]), "+v"(P[14]), "+v"(P[15]) : "v"(ub[3][0]), "v"(ub[3][1]), "v"(ub[3][2]));
            asm volatile("ds_read_b128 %0, %1 offset:176" : "=v"(ub[3][0]) : "v"(oaddr) : "memory");
            asm volatile("ds_read_b128 %0, %1 offset:432" : "=v"(ub[3][1]) : "v"(oaddr) : "memory");
            asm volatile("ds_read_b128 %0, %1 offset:688" : "=v"(ub[3][2]) : "v"(oaddr) : "memory");
            asm volatile("s_waitcnt lgkmcnt(9)" : "+v"(ub[0][0]), "+v"(ub[0][1]), "+v"(ub[0][2]) :: "memory");
            { const f32x2 w0 = {ub[0][0][0], ub[0][0][1]}, b0 = {ub[0][1][0], ub[0][1][1]}, d0 = {ub[0][2][0], ub[0][2][1]}; S[16] = S[16] * w0 + sav * b0 + vvv * d0; P[16] = P[16] * w0 + spv * b0; }
            { const f32x2 w1 = {ub[0][0][2], ub[0][0][3]}, b1 = {ub[0][1][2], ub[0][1][3]}, d1 = {ub[0][2][2], ub[0][2][3]}; S[17] = S[17] * w1 + sav * b1 + vvv * d1; P[17] = P[17] * w1 + spv * b1; }
            asm volatile("" : "+v"(S[16]), "+v"(S[17]), "+v"(P[16]), "+v"(P[17]) : "v"(ub[0][0]), "v"(ub[0][1]), "v"(ub[0][2]));
            asm volatile("ds_read_b128 %0, %1 offset:192" : "=v"(ub[0][0]) : "v"(oaddr) : "memory");
            asm volatile("ds_read_b128 %0, %1 offset:448" : "=v"(ub[0][1]) : "v"(oaddr) : "memory");
            asm volatile("ds_read_b128 %0, %1 offset:704" : "=v"(ub[0][2]) : "v"(oaddr) : "memory");
            asm volatile("s_waitcnt lgkmcnt(9)" : "+v"(ub[1][0]), "+v"(ub[1][1]), "+v"(ub[1][2]) :: "memory");
            { const f32x2 w0 = {ub[1][0][0], ub[1][0][1]}, b0 = {ub[1][1][0], ub[1][1][1]}, d0 = {ub[1][2][0], ub[1][2][1]}; S[18] = S[18] * w0 + sav * b0 + vvv * d0; P[18] = P[18] * w0 + spv * b0; }
            { const f32x2 w1 = {ub[1][0][2], ub[1][0][3]}, b1 = {ub[1][1][2], ub[1][1][3]}, d1 = {ub[1][2][2], ub[1][2][3]}; S[19] = S[19] * w1 + sav * b1 + vvv * d1; P[19] = P[19] * w1 + spv * b1; }
            asm volatile("" : "+v"(S[18]), "+v"(S[19]), "+v"(P[18]), "+v"(P[19]) : "v"(ub[1][0]), "v"(ub[1][1]), "v"(ub[1][2]));
            asm volatile("ds_read_b128 %0, %1 offset:208" : "=v"(ub[1][0]) : "v"(oaddr) : "memory");
            asm volatile("ds_read_b128 %0, %1 offset:464" : "=v"(ub[1][1]) : "v"(oaddr) : "memory");
            asm volatile("ds_read_b128 %0, %1 offset:720" : "=v"(ub[1][2]) : "v"(oaddr) : "memory");
            asm volatile("s_waitcnt lgkmcnt(9)" : "+v"(ub[2][0]), "+v"(ub[2][1]), "+v"(ub[2][2]) :: "memory");
            { const f32x2 w0 = {ub[2][0][0], ub[2][0][1]}, b0 = {ub[2][1][0], ub[2][1][1]}, d0 = {ub[2][2][0], ub[2][2][1]}; S[20] = S[20] * w0 + sav * b0 + vvv * d0; P[20] = P[20] * w0 + spv * b0; }
            { const f32x2 w1 = {ub[2][0][2], ub[2][0][3]}, b1 = {ub[2][1][2], ub[2][1][3]}, d1 = {ub[2][2][2], ub[2][2][3]}; S[21] = S[21] * w1 + sav * b1 + vvv * d1; P[21] = P[21] * w1 + spv * b1; }
            asm volatile("" : "+v"(S[20]), "+v"(S[21]), "+v"(P[20]), "+v"(P[21]) : "v"(ub[2][0]), "v"(ub[2][1]), "v"(ub[2][2]));
            asm volatile("ds_read_b128 %0, %1 offset:224" : "=v"(ub[2][0]) : "v"(oaddr) : "memory");
            asm volatile("ds_read_b128 %0, %1 offset:480" : "=v"(ub[2][1]) : "v"(oaddr) : "memory");
            asm volatile("ds_read_b128 %0, %1 offset:736" : "=v"(ub[2][2]) : "v"(oaddr) : "memory");
            asm volatile("s_waitcnt lgkmcnt(9)" : "+v"(ub[3][0]), "+v"(ub[3][1]), "+v"(ub[3][2]) :: "memory");
            { const f32x2 w0 = {ub[3][0][0], ub[3][0][1]}, b0 = {ub[3][1][0], ub[3][1][1]}, d0 = {ub[3][2][0], ub[3][2][1]}; S[22] = S[22] * w0 + sav * b0 + vvv * d0; P[22] = P[22] * w0 + spv * b0; }
            { const f32x2 w1 = {ub[3][0][2], ub[3][0][3]}, b1 = {ub[3][1][2], ub[3][1][3]}, d1 = {ub[3][2][2], ub[3][2][3]}; S[23] = S[23] * w1 + sav * b1 + vvv * d1; P[23] = P[23] * w1 + spv * b1; }
            asm volatile("" : "+v"(S[22]), "+v"(S[23]), "+v"(P[22]), "+v"(P[23]) : "v"(ub[3][0]), "v"(ub[3][1]), "v"(ub[3][2]));
            asm volatile("ds_read_b128 %0, %1 offset:240" : "=v"(ub[3][0]) : "v"(oaddr) : "memory");
            asm volatile("ds_read_b128 %0, %1 offset:496" : "=v"(ub[3][1]) : "v"(oaddr) : "memory");
            asm volatile("ds_read_b128 %0, %1 offset:752" : "=v"(ub[3][2]) : "v"(oaddr) : "memory");
            asm volatile("s_waitcnt lgkmcnt(9)" : "+v"(ub[0][0]), "+v"(ub[0][1]), "+v"(ub[0][2]) :: "memory");
            { const f32x2 w0 = {ub[0][0][0], ub[0][0][1]}, b0 = {ub[0][1][0], ub[0][1][1]}, d0 = {ub[0][2][0], ub[0][2][1]}; S[24] = S[24] * w0 + sav * b0 + vvv * d0; P[24] = P[24] * w0 + spv * b0; }
            { const f32x2 w1 = {ub[0][0][2], ub[0][0][3]}, b1 = {ub[0][1][2], ub[0][1][3]}, d1 = {ub[0][2][2], ub[0][2][3]}; S[25] = S[25] * w1 + sav * b1 + vvv * d1; P[25] = P[25] * w1 + spv * b1; }
            asm volatile("" : "+v"(S[24]), "+v"(S[25]), "+v"(P[24]), "+v"(P[25]) : "v"(ub[0][0]), "v"(ub[0][1]), "v"(ub[0][2]));
            asm volatile("ds_read_b128 %0, %1 offset:768" : "=v"(nk[0]) : "v"(naddr) : "memory");
            asm volatile("ds_read_b128 %0, %1 offset:784" : "=v"(nk[1]) : "v"(naddr) : "memory");
            asm volatile("s_waitcnt lgkmcnt(8)" : "+v"(ub[1][0]), "+v"(ub[1][1]), "+v"(ub[1][2]) :: "memory");
            { const f32x2 w0 = {ub[1][0][0], ub[1][0][1]}, b0 = {ub[1][1][0], ub[1][1][1]}, d0 = {ub[1][2][0], ub[1][2][1]}; S[26] = S[26] * w0 + sav * b0 + vvv * d0; P[26] = P[26] * w0 + spv * b0; }
            { const f32x2 w1 = {ub[1][0][2], ub[1][0][3]}, b1 = {ub[1][1][2], ub[1][1][3]}, d1 = {ub[1][2][2], ub[1][2][3]}; S[27] = S[27] * w1 + sav * b1 + vvv * d1; P[27] = P[27] * w1 + spv * b1; }
            asm volatile("" : "+v"(S[26]), "+v"(S[27]), "+v"(P[26]), "+v"(P[27]) : "v"(ub[1][0]), "v"(ub[1][1]), "v"(ub[1][2]));
            asm volatile("ds_read_b128 %0, %1 offset:800" : "=v"(nk[2]) : "v"(naddr) : "memory");
            asm volatile("ds_read_b128 %0, %1 offset:816" : "=v"(nk[3]) : "v"(naddr) : "memory");
            asm volatile("s_waitcnt lgkmcnt(7)" : "+v"(ub[2][0]), "+v"(ub[2][1]), "+v"(ub[2][2]) :: "memory");
            { const f32x2 w0 = {ub[2][0][0], ub[2][0][1]}, b0 = {ub[2][1][0], ub[2][1][1]}, d0 = {ub[2][2][0], ub[2][2][1]}; S[28] = S[28] * w0 + sav * b0 + vvv * d0; P[28] = P[28] * w0 + spv * b0; }
            { const f32x2 w1 = {ub[2][0][2], ub[2][0][3]}, b1 = {ub[2][1][2], ub[2][1][3]}, d1 = {ub[2][2][2], ub[2][2][3]}; S[29] = S[29] * w1 + sav * b1 + vvv * d1; P[29] = P[29] * w1 + spv * b1; }
            asm volatile("" : "+v"(S[28]), "+v"(S[29]), "+v"(P[28]), "+v"(P[29]) : "v"(ub[2][0]), "v"(ub[2][1]), "v"(ub[2][2]));
            asm volatile("ds_read_b128 %0, %1 offset:832" : "=v"(nk[4]) : "v"(naddr) : "memory");
            asm volatile("ds_read_b128 %0, %1 offset:848" : "=v"(nk[5]) : "v"(naddr) : "memory");
            asm volatile("s_waitcnt lgkmcnt(6)" : "+v"(ub[3][0]), "+v"(ub[3][1]), "+v"(ub[3][2]) :: "memory");
            { const f32x2 w0 = {ub[3][0][0], ub[3][0][1]}, b0 = {ub[3][1][0], ub[3][1][1]}, d0 = {ub[3][2][0], ub[3][2][1]}; S[30] = S[30] * w0 + sav * b0 + vvv * d0; P[30] = P[30] * w0 + spv * b0; }
            { const f32x2 w1 = {ub[3][0][2], ub[3][0][3]}, b1 = {ub[3][1][2], ub[3][1][3]}, d1 = {ub[3][2][2], ub[3][2][3]}; S[31] = S[31] * w1 + sav * b1 + vvv * d1; P[31] = P[31] * w1 + spv * b1; }
            asm volatile("" : "+v"(S[30]), "+v"(S[31]), "+v"(P[30]), "+v"(P[31]) : "v"(ub[3][0]), "v"(ub[3][1]), "v"(ub[3][2]));
            asm volatile("ds_read_b128 %0, %1 offset:864" : "=v"(nk[6]) : "v"(naddr) : "memory");
            asm volatile("ds_read_b128 %0, %1 offset:880" : "=v"(nk[7]) : "v"(naddr) : "memory");

            } else {
            f32x2 sa2 = {0.f, 0.f}, sp2 = {0.f, 0.f}; float vvn;
            asm volatile("ds_read_b32 %0, %1 offset:1280" : "=v"(vvn) : "v"(vaddr) : "memory");
            asm volatile("s_waitcnt lgkmcnt(8)" : "+v"(nk[0]) :: "memory");
            { const f32x2 n0 = {nk[0][0], nk[0][1]}, n1 = {nk[0][2], nk[0][3]}; sa2 += S[0] * n0; sa2 += S[1] * n1; }
            asm volatile("" : "+v"(sa2) : "v"(nk[0]));
            asm volatile("ds_read_b128 %0, %1 offset:896" : "=v"(nk[0]) : "v"(oaddr) : "memory");
            asm volatile("s_waitcnt lgkmcnt(8)" : "+v"(nk[1]) :: "memory");
            { const f32x2 n0 = {nk[1][0], nk[1][1]}, n1 = {nk[1][2], nk[1][3]}; sa2 += S[2] * n0; sa2 += S[3] * n1; }
            asm volatile("" : "+v"(sa2) : "v"(nk[1]));
            asm volatile("ds_read_b128 %0, %1 offset:912" : "=v"(nk[1]) : "v"(oaddr) : "memory");
            asm volatile("s_waitcnt lgkmcnt(8)" : "+v"(nk[2]) :: "memory");
            { const f32x2 n0 = {nk[2][0], nk[2][1]}, n1 = {nk[2][2], nk[2][3]}; sa2 += S[4] * n0; sa2 += S[5] * n1; }
            asm volatile("" : "+v"(sa2) : "v"(nk[2]));
            asm volatile("ds_read_b128 %0, %1 offset:928" : "=v"(nk[2]) : "v"(oaddr) : "memory");
            asm volatile("s_waitcnt lgkmcnt(8)" : "+v"(nk[3]) :: "memory");
            { const f32x2 n0 = {nk[3][0], nk[3][1]}, n1 = {nk[3][2], nk[3][3]}; sa2 += S[6] * n0; sa2 += S[7] * n1; }
            asm volatile("" : "+v"(sa2) : "v"(nk[3]));
            asm volatile("ds_read_b128 %0, %1 offset:944" : "=v"(nk[3]) : "v"(oaddr) : "memory");
            asm volatile("s_waitcnt lgkmcnt(8)" : "+v"(nk[4]) :: "memory");
            { const f32x2 n0 = {nk[4][0], nk[4][1]}, n1 = {nk[4][2], nk[4][3]}; sa2 += S[8] * n0; sa2 += S[9] * n1; }
            asm volatile("" : "+v"(sa2) : "v"(nk[4]));
            asm volatile("ds_read_b128 %0, %1 offset:960" : "=v"(nk[4]) : "v"(oaddr) : "memory");
            asm volatile("s_waitcnt lgkmcnt(8)" : "+v"(nk[5]) :: "memory");
            { const f32x2 n0 = {nk[5][0], nk[5][1]}, n1 = {nk[5][2], nk[5][3]}; sa2 += S[10] * n0; sa2 += S[11] * n1; }
            asm volatile("" : "+v"(sa2) : "v"(nk[5]));
            asm volatile("ds_read_b128 %0, %1 offset:976" : "=v"(nk[5]) : "v"(oaddr) : "memory");
            asm volatile("s_waitcnt lgkmcnt(8)" : "+v"(nk[6]) :: "memory");
            { const f32x2 n0 = {nk[6][0], nk[6][1]}, n1 = {nk[6][2], nk[6][3]}; sa2 += S[12] * n0; sa2 += S[13] * n1; }
            asm volatile("" : "+v"(sa2) : "v"(nk[6]));
            asm volatile("ds_read_b128 %0, %1 offset:992" : "=v"(nk[6]) : "v"(oaddr) : "memory");
            asm volatile("s_waitcnt lgkmcnt(8)" : "+v"(nk[7]) :: "memory");
            { const f32x2 n0 = {nk[7][0], nk[7][1]}, n1 = {nk[7][2], nk[7][3]}; sa2 += S[14] * n0; sa2 += S[15] * n1; }
            asm volatile("" : "+v"(sa2) : "v"(nk[7]));
            asm volatile("ds_read_b128 %0, %1 offset:1008" : "=v"(nk[7]) : "v"(oaddr) : "memory");
            asm volatile("s_waitcnt lgkmcnt(7)" : "+v"(nk[0]), "+v"(vvn) :: "memory");
            const float vv = vvn;
            { const f32x2 n0 = {nk[0][0], nk[0][1]}, n1 = {nk[0][2], nk[0][3]}; sa2 += S[16] * n0; sa2 += S[17] * n1; }
            asm volatile("" : "+v"(sa2) : "v"(nk[0]));
            asm volatile("s_waitcnt lgkmcnt(6)" : "+v"(nk[1]) :: "memory");
            { const f32x2 n0 = {nk[1][0], nk[1][1]}, n1 = {nk[1][2], nk[1][3]}; sa2 += S[18] * n0; sa2 += S[19] * n1; }
            asm volatile("" : "+v"(sa2) : "v"(nk[1]));
            asm volatile("ds_read_b128 %0, %1 offset:0" : "=v"(ub[0][0]) : "v"(oaddr) : "memory");
            asm volatile("ds_read_b128 %0, %1 offset:256" : "=v"(ub[0][1]) : "v"(oaddr) : "memory");
            asm volatile("ds_read_b128 %0, %1 offset:512" : "=v"(ub[0][2]) : "v"(oaddr) : "memory");
            asm volatile("ds_read_b128 %0, %1 offset:1024" : "=v"(ub[0][3]) : "v"(oaddr) : "memory");
            asm volatile("s_waitcnt lgkmcnt(9)" : "+v"(nk[2]) :: "memory");
            { const f32x2 n0 = {nk[2][0], nk[2][1]}, n1 = {nk[2][2], nk[2][3]}; sa2 += S[20] * n0; sa2 += S[21] * n1; }
            asm volatile("" : "+v"(sa2) : "v"(nk[2]));
            asm volatile("s_waitcnt lgkmcnt(8)" : "+v"(nk[3]) :: "memory");
            { const f32x2 n0 = {nk[3][0], nk[3][1]}, n1 = {nk[3][2], nk[3][3]}; sa2 += S[22] * n0; sa2 += S[23] * n1; }
            asm volatile("" : "+v"(sa2) : "v"(nk[3]));
            asm volatile("ds_read_b128 %0, %1 offset:16" : "=v"(ub[1][0]) : "v"(oaddr) : "memory");
            asm volatile("ds_read_b128 %0, %1 offset:272" : "=v"(ub[1][1]) : "v"(oaddr) : "memory");
            asm volatile("ds_read_b128 %0, %1 offset:528" : "=v"(ub[1][2]) : "v"(oaddr) : "memory");
            asm volatile("ds_read_b128 %0, %1 offset:1040" : "=v"(ub[1][3]) : "v"(oaddr) : "memory");
            asm volatile("s_waitcnt lgkmcnt(11)" : "+v"(nk[4]) :: "memory");
            { const f32x2 n0 = {nk[4][0], nk[4][1]}, n1 = {nk[4][2], nk[4][3]}; sa2 += S[24] * n0; sa2 += S[25] * n1; }
            asm volatile("" : "+v"(sa2) : "v"(nk[4]));
            asm volatile("s_waitcnt lgkmcnt(10)" : "+v"(nk[5]) :: "memory");
            { const f32x2 n0 = {nk[5][0], nk[5][1]}, n1 = {nk[5][2], nk[5][3]}; sa2 += S[26] * n0; sa2 += S[27] * n1; }
            asm volatile("" : "+v"(sa2) : "v"(nk[5]));
            asm volatile("ds_read_b128 %0, %1 offset:32" : "=v"(ub[2][0]) : "v"(oaddr) : "memory");
            asm volatile("ds_read_b128 %0, %1 offset:288" : "=v"(ub[2][1]) : "v"(oaddr) : "memory");
            asm volatile("ds_read_b128 %0, %1 offset:544" : "=v"(ub[2][2]) : "v"(oaddr) : "memory");
            asm volatile("ds_read_b128 %0, %1 offset:1056" : "=v"(ub[2][3]) : "v"(oaddr) : "memory");
            asm volatile("s_waitcnt lgkmcnt(13)" : "+v"(nk[6]) :: "memory");
            { const f32x2 n0 = {nk[6][0], nk[6][1]}, n1 = {nk[6][2], nk[6][3]}; sa2 += S[28] * n0; sa2 += S[29] * n1; }
            asm volatile("" : "+v"(sa2) : "v"(nk[6]));
            asm volatile("s_waitcnt lgkmcnt(12)" : "+v"(nk[7]) :: "memory");
            { const f32x2 n0 = {nk[7][0], nk[7][1]}, n1 = {nk[7][2], nk[7][3]}; sa2 += S[30] * n0; sa2 += S[31] * n1; }
            asm volatile("" : "+v"(sa2) : "v"(nk[7]));
            const float sa = sa2[0] + sa2[1], sp = sp2[0] + sp2[1]; const f32x2 sav = {sa, sa}, spv = {sp, sp}, vvv = {vv, vv}; f32x2 y2 = {0.f, 0.f}; (void)spv; (void)sp;
            asm volatile("s_waitcnt lgkmcnt(8)" : "+v"(ub[0][0]), "+v"(ub[0][1]), "+v"(ub[0][2]), "+v"(ub[0][3]) :: "memory");
            { const f32x2 w0 = {ub[0][0][0], ub[0][0][1]}, b0 = {ub[0][1][0], ub[0][1][1]}, d0 = {ub[0][2][0], ub[0][2][1]}; const f32x2 r0 = {ub[0][3][0], ub[0][3][1]}; S[0] = S[0] * w0 + sav * b0 + vvv * d0; y2 += S[0] * r0; }
            { const f32x2 w1 = {ub[0][0][2], ub[0][0][3]}, b1 = {ub[0][1][2], ub[0][1][3]}, d1 = {ub[0][2][2], ub[0][2][3]}; const f32x2 r1 = {ub[0][3][2], ub[0][3][3]}; S[1] = S[1] * w1 + sav * b1 + vvv * d1; y2 += S[1] * r1; }
            asm volatile("" : "+v"(S[0]), "+v"(S[1]), "+v"(y2) : "v"(ub[0][0]), "v"(ub[0][1]), "v"(ub[0][2]), "v"(ub[0][3]));
            asm volatile("ds_read_b128 %0, %1 offset:48" : "=v"(ub[0][0]) : "v"(oaddr) : "memory");
            asm volatile("ds_read_b128 %0, %1 offset:304" : "=v"(ub[0][1]) : "v"(oaddr) : "memory");
            asm volatile("ds_read_b128 %0, %1 offset:560" : "=v"(ub[0][2]) : "v"(oaddr) : "memory");
            asm volatile("ds_read_b128 %0, %1 offset:1072" : "=v"(ub[0][3]) : "v"(oaddr) : "memory");
            asm volatile("s_waitcnt lgkmcnt(8)" : "+v"(ub[1][0]), "+v"(ub[1][1]), "+v"(ub[1][2]), "+v"(ub[1][3]) :: "memory");
            { const f32x2 w0 = {ub[1][0][0], ub[1][0][1]}, b0 = {ub[1][1][0], ub[1][1][1]}, d0 = {ub[1][2][0], ub[1][2][1]}; const f32x2 r0 = {ub[1][3][0], ub[1][3][1]}; S[2] = S[2] * w0 + sav * b0 + vvv * d0; y2 += S[2] * r0; }
            { const f32x2 w1 = {ub[1][0][2], ub[1][0][3]}, b1 = {ub[1][1][2], ub[1][1][3]}, d1 = {ub[1][2][2], ub[1][2][3]}; const f32x2 r1 = {ub[1][3][2], ub[1][3][3]}; S[3] = S[3] * w1 + sav * b1 + vvv * d1; y2 += S[3] * r1; }
            asm volatile("" : "+v"(S[2]), "+v"(S[3]), "+v"(y2) : "v"(ub[1][0]), "v"(ub[1][1]), "v"(ub[1][2]), "v"(ub[1][3]));
            asm volatile("ds_read_b128 %0, %1 offset:64" : "=v"(ub[1][0]) : "v"(oaddr) : "memory");
            asm volatile("ds_read_b128 %0, %1 offset:320" : "=v"(ub[1][1]) : "v"(oaddr) : "memory");
            asm volatile("ds_read_b128 %0, %1 offset:576" : "=v"(ub[1][2]) : "v"(oaddr) : "memory");
            asm volatile("ds_read_b128 %0, %1 offset:1088" : "=v"(ub[1][3]) : "v"(oaddr) : "memory");
            asm volatile("s_waitcnt lgkmcnt(8)" : "+v"(ub[2][0]), "+v"(ub[2][1]), "+v"(ub[2][2]), "+v"(ub[2][3]) :: "memory");
            { const f32x2 w0 = {ub[2][0][0], ub[2][0][1]}, b0 = {ub[2][1][0], ub[2][1][1]}, d0 = {ub[2][2][0], ub[2][2][1]}; const f32x2 r0 = {ub[2][3][0], ub[2][3][1]}; S[4] = S[4] * w0 + sav * b0 + vvv * d0; y2 += S[4] * r0; }
            { const f32x2 w1 = {ub[2][0][2], ub[2][0][3]}, b1 = {ub[2][1][2], ub[2][1][3]}, d1 = {ub[2][2][2], ub[2][2][3]}; const f32x2 r1 = {ub[2][3][2], ub[2][3][3]}; S[5] = S[5] * w1 + sav * b1 + vvv * d1; y2 += S[5] * r1; }
            asm volatile("" : "+v"(S[4]), "+v"(S[5]), "+v"(y2) : "v"(ub[2][0]), "v"(ub[2][1]), "v"(ub[2][2]), "v"(ub[2][3]));
            asm volatile("ds_read_b128 %0, %1 offset:80" : "=v"(ub[2][0]) : "v"(oaddr) : "memory");
            asm volatile("ds_read_b128 %0, %1 offset:336" : "=v"(ub[2][1]) : "v"(oaddr) : "memory");
            asm volatile("ds_read_b128 %0, %1 offset:592" : "=v"(ub[2][2]) : "v"(oaddr) : "memory");
            asm volatile("ds_read_b128 %0, %1 offset:1104" : "=v"(ub[2][3]) : "v"(oaddr) : "memory");
            asm volatile("s_waitcnt lgkmcnt(8)" : "+v"(ub[0][0]), "+v"(ub[0][1]), "+v"(ub[0][2]), "+v"(ub[0][3]) :: "memory");
            { const f32x2 w0 = {ub[0][0][0], ub[0][0][1]}, b0 = {ub[0][1][0], ub[0][1][1]}, d0 = {ub[0][2][0], ub[0][2][1]}; const f32x2 r0 = {ub[0][3][0], ub[0][3][1]}; S[6] = S[6] * w0 + sav * b0 + vvv * d0; y2 += S[6] * r0; }
            { const f32x2 w1 = {ub[0][0][2], ub[0][0][3]}, b1 = {ub[0][1][2], ub[0][1][3]}, d1 = {ub[0][2][2], ub[0][2][3]}; const f32x2 r1 = {ub[0][3][2], ub[0][3][3]}; S[7] = S[7] * w1 + sav * b1 + vvv * d1; y2 += S[7] * r1; }
            asm volatile("" : "+v"(S[6]), "+v"(S[7]), "+v"(y2) : "v"(ub[0][0]), "v"(ub[0][1]), "v"(ub[0][2]), "v"(ub[0][3]));
            asm volatile("ds_read_b128 %0, %1 offset:96" : "=v"(ub[0][0]) : "v"(oaddr) : "memory");
            asm volatile("ds_read_b128 %0, %1 offset:352" : "=v"(ub[0][1]) : "v"(oaddr) : "memory");
            asm volatile("ds_read_b128 %0, %1 offset:608" : "=v"(ub[0][2]) : "v"(oaddr) : "memory");
            asm volatile("ds_read_b128 %0, %1 offset:1120" : "=v"(ub[0][3]) : "v"(oaddr) : "memory");
            asm volatile("s_waitcnt lgkmcnt(8)" : "+v"(ub[1][0]), "+v"(ub[1][1]), "+v"(ub[1][2]), "+v"(ub[1][3]) :: "memory");
            { const f32x2 w0 = {ub[1][0][0], ub[1][0][1]}, b0 = {ub[1][1][0], ub[1][1][1]}, d0 = {ub[1][2][0], ub[1][2][1]}; const f32x2 r0 = {ub[1][3][0], ub[1][3][1]}; S[8] = S[8] * w0 + sav * b0 + vvv * d0; y2 += S[8] * r0; }
            { const f32x2 w1 = {ub[1][0][2], ub[1][0][3]}, b1 = {ub[1][1][2], ub[1][1][3]}, d1 = {ub[1][2][2], ub[1][2][3]}; const f32x2 r1 = {ub[1][3][2], ub[1][3][3]}; S[9] = S[9] * w1 + sav * b1 + vvv * d1; y2 += S[9] * r1; }
            asm volatile("" : "+v"(S[8]), "+v"(S[9]), "+v"(y2) : "v"(ub[1][0]), "v"(ub[1][1]), "v"(ub[1][2]), "v"(ub[1][3]));
            asm volatile("ds_read_b128 %0, %1 offset:112" : "=v"(ub[1][0]) : "v"(oaddr) : "memory");
            asm volatile("ds_read_b128 %0, %1 offset:368" : "=v"(ub[1][1]) : "v"(oaddr) : "memory");
            asm volatile("ds_read_b128 %0, %1 offset:624" : "=v"(ub[1][2]) : "v"(oaddr) : "memory");
            asm volatile("ds_read_b128 %0, %1 offset:1136" : "=v"(ub[1][3]) : "v"(oaddr) : "memory");
            asm volatile("s_waitcnt lgkmcnt(8)" : "+v"(ub[2][0]), "+v"(ub[2][1]), "+v"(ub[2][2]), "+v"(ub[2][3]) :: "memory");
            { const f32x2 w0 = {ub[2][0][0], ub[2][0][1]}, b0 = {ub[2][1][0], ub[2][1][1]}, d0 = {ub[2][2][0], ub[2][2][1]}; const f32x2 r0 = {ub[2][3][0], ub[2][3][1]}; S[10] = S[10] * w0 + sav * b0 + vvv * d0; y2 += S[10] * r0; }
            { const f32x2 w1 = {ub[2][0][2], ub[2][0][3]}, b1 = {ub[2][1][2], ub[2][1][3]}, d1 = {ub[2][2][2], ub[2][2][3]}; const f32x2 r1 = {ub[2][3][2], ub[2][3][3]}; S[11] = S[11] * w1 + sav * b1 + vvv * d1; y2 += S[11] * r1; }
            asm volatile("" : "+v"(S[10]), "+v"(S[11]), "+v"(y2) : "v"(ub[2][0]), "v"(ub[2][1]), "v"(ub[2][2]), "v"(ub[2][3]));
            asm volatile("ds_read_b128 %0, %1 offset:128" : "=v"(ub[2][0]) : "v"(oaddr) : "memory");
            asm volatile("ds_read_b128 %0, %1 offset:384" : "=v"(ub[2][1]) : "v"(oaddr) : "memory");
            asm volatile("ds_read_b128 %0, %1 offset:640" : "=v"(ub[2][2]) : "v"(oaddr) : "memory");
            asm volatile("ds_read_b128 %0, %1 offset:1152" : "=v"(ub[2][3]) : "v"(oaddr) : "memory");
            asm volatile("s_waitcnt lgkmcnt(8)" : "+v"(ub[0][0]), "+v"(ub[0][1]), "+v"(ub[0][2]), "+v"(ub[0][3]) :: "memory");
            { const f32x2 w0 = {ub[0][0][0], ub[0][0][1]}, b0 = {ub[0][1][0], ub[0][1][1]}, d0 = {ub[0][2][0], ub[0][2][1]}; const f32x2 r0 = {ub[0][3][0], ub[0][3][1]}; S[12] = S[12] * w0 + sav * b0 + vvv * d0; y2 += S[12] * r0; }
            { const f32x2 w1 = {ub[0][0][2], ub[0][0][3]}, b1 = {ub[0][1][2], ub[0][1][3]}, d1 = {ub[0][2][2], ub[0][2][3]}; const f32x2 r1 = {ub[0][3][2], ub[0][3][3]}; S[13] = S[13] * w1 + sav * b1 + vvv * d1; y2 += S[13] * r1; }
            asm volatile("" : "+v"(S[12]), "+v"(S[13]), "+v"(y2) : "v"(ub[0][0]), "v"(ub[0][1]), "v"(ub[0][2]), "v"(ub[0][3]));
            asm volatile("ds_read_b128 %0, %1 offset:144" : "=v"(ub[0][0]) : "v"(oaddr) : "memory");
            asm volatile("ds_read_b128 %0, %1 offset:400" : "=v"(ub[0][1]) : "v"(oaddr) : "memory");
            asm volatile("ds_read_b128 %0, %1 offset:656" : "=v"(ub[0][2]) : "v"(oaddr) : "memory");
            asm volatile("ds_read_b128 %0, %1 offset:1168" : "=v"(ub[0][3]) : "v"(oaddr) : "memory");
            asm volatile("s_waitcnt lgkmcnt(8)" : "+v"(ub[1][0]), "+v"(ub[1][1]), "+v"(ub[1][2]), "+v"(ub[1][3]) :: "memory");
            { const f32x2 w0 = {ub[1][0][0], ub[1][0][1]}, b0 = {ub[1][1][0], ub[1][1][1]}, d0 = {ub[1][2][0], ub[1][2][1]}; const f32x2 r0 = {ub[1][3][0], ub[1][3][1]}; S[14] = S[14] * w0 + sav * b0 + vvv * d0; y2 += S[14] * r0; }
            { const f32x2 w1 = {ub[1][0][2], ub[1][0][3]}, b1 = {ub[1][1][2], ub[1][1][3]}, d1 = {ub[1][2][2], ub[1][2][3]}; const f32x2 r1 = {ub[1][3][2], ub[1][3][3]}; S[15] = S[15] * w1 + sav * b1 + vvv * d1; y2 += S[15] * r1; }
            asm volatile("" : "+v"(S[14]), "+v"(S[15]), "+v"(y2) : "v"(ub[1][0]), "v"(ub[1][1]), "v"(ub[1][2]), "v"(ub[1][3]));
            asm volatile("ds_read_b128 %0, %1 offset:160" : "=v"(ub[1][0]) : "v"(oaddr) : "memory");
            asm volatile("ds_read_b128 %0, %1 offset:416" : "=v"(ub[1][1]) : "v"(oaddr) : "memory");
            asm volatile("ds_read_b128 %0, %1 offset:672" : "=v"(ub[1][2]) : "v"(oaddr) : "memory");
            asm volatile("ds_read_b128 %0, %1 offset:1184" : "=v"(ub[1][3]) : "v"(oaddr) : "memory");
            asm volatile("s_waitcnt lgkmcnt(8)" : "+v"(ub[2][0]), "+v"(ub[2][1]), "+v"(ub[2][2]), "+v"(ub[2][3]) :: "memory");
            { const f32x2 w0 = {ub[2][0][0], ub[2][0][1]}, b0 = {ub[2][1][0], ub[2][1][1]}, d0 = {ub[2][2][0], ub[2][2][1]}; const f32x2 r0 = {ub[2][3][0], ub[2][3][1]}; S[16] = S[16] * w0 + sav * b0 + vvv * d0; y2 += S[16] * r0; }
            { const f32x2 w1 = {ub[2][0][2], ub[2][0][3]}, b1 = {ub[2][1][2], ub[2][1][3]}, d1 = {ub[2][2][2], ub[2][2][3]}; const f32x2 r1 = {ub[2][3][2], ub[2][3][3]}; S[17] = S[17] * w1 + sav * b1 + vvv * d1; y2 += S[17] * r1; }
            asm volatile("" : "+v"(S[16]), "+v"(S[17]), "+v"(y2) : "v"(ub[2][0]), "v"(ub[2][1]), "v"(ub[2][2]), "v"(ub[2][3]));
            asm volatile("ds_read_b128 %0, %1 offset:176" : "=v"(ub[2][0]) : "v"(oaddr) : "memory");
            asm volatile("ds_read_b128 %0, %1 offset:432" : "=v"(ub[2][1]) : "v"(oaddr) : "memory");
            asm volatile("ds_read_b128 %0, %1 offset:688" : "=v"(ub[2][2]) : "v"(oaddr) : "memory");
            asm volatile("ds_read_b128 %0, %1 offset:1200" : "=v"(ub[2][3]) : "v"(oaddr) : "memory");
            asm volatile("s_waitcnt lgkmcnt(8)" : "+v"(ub[0][0]), "+v"(ub[0][1]), "+v"(ub[0][2]), "+v"(ub[0][3]) :: "memory");
            { const f32x2 w0 = {ub[0][0][0], ub[0][0][1]}, b0 = {ub[0][1][0], ub[0][1][1]}, d0 = {ub[0][2][0], ub[0][2][1]}; const f32x2 r0 = {ub[0][3][0], ub[0][3][1]}; S[18] = S[18] * w0 + sav * b0 + vvv * d0; y2 += S[18] * r0; }
            { const f32x2 w1 = {ub[0][0][2], ub[0][0][3]}, b1 = {ub[0][1][2], ub[0][1][3]}, d1 = {ub[0][2][2], ub[0][2][3]}; const f32x2 r1 = {ub[0][3][2], ub[0][3][3]}; S[19] = S[19] * w1 + sav * b1 + vvv * d1; y2 += S[19] * r1; }
            asm volatile("" : "+v"(S[18]), "+v"(S[19]), "+v"(y2) : "v"(ub[0][0]), "v"(ub[0][1]), "v"(ub[0][2]), "v"(ub[0][3]));
            asm volatile("ds_read_b128 %0, %1 offset:192" : "=v"(ub[0][0]) : "v"(oaddr) : "memory");
            asm volatile("ds_read_b128 %0, %1 offset:448" : "=v"(ub[0][1]) : "v"(oaddr) : "memory");
            asm volatile("ds_read_b128 %0, %1 offset:704" : "=v"(ub[0][2]) : "v"(oaddr) : "memory");
            asm volatile("ds_read_b128 %0, %1 offset:1216" : "=v"(ub[0][3]) : "v"(oaddr) : "memory");
            asm volatile("s_waitcnt lgkmcnt(8)" : "+v"(ub[1][0]), "+v"(ub[1][1]), "+v"(ub[1][2]), "+v"(ub[1][3]) :: "memory");
            { const f32x2 w0 = {ub[1][0][0], ub[1][0][1]}, b0 = {ub[1][1][0], ub[1][1][1]}, d0 = {ub[1][2][0], ub[1][2][1]}; const f32x2 r0 = {ub[1][3][0], ub[1][3][1]}; S[20] = S[20] * w0 + sav * b0 + vvv * d0; y2 += S[20] * r0; }
            { const f32x2 w1 = {ub[1][0][2], ub[1][0][3]}, b1 = {ub[1][1][2], ub[1][1][3]}, d1 = {ub[1][2][2], ub[1][2][3]}; const f32x2 r1 = {ub[1][3][2], ub[1][3][3]}; S[21] = S[21] * w1 + sav * b1 + vvv * d1; y2 += S[21] * r1; }
            asm volatile("" : "+v"(S[20]), "+v"(S[21]), "+v"(y2) : "v"(ub[1][0]), "v"(ub[1][1]), "v"(ub[1][2]), "v"(ub[1][3]));
            asm volatile("ds_read_b128 %0, %1 offset:208" : "=v"(ub[1][0]) : "v"(oaddr) : "memory");
            asm volatile("ds_read_b128 %0, %1 offset:464" : "=v"(ub[1][1]) : "v"(oaddr) : "memory");
            asm volatile("ds_read_b128 %0, %1 offset:720" : "=v"(ub[1][2]) : "v"(oaddr) : "memory");
            asm volatile("ds_read_b128 %0, %1 offset:1232" : "=v"(ub[1][3]) : "v"(oaddr) : "memory");
            asm volatile("s_waitcnt lgkmcnt(8)" : "+v"(ub[2][0]), "+v"(ub[2][1]), "+v"(ub[2][2]), "+v"(ub[2][3]) :: "memory");
            { const f32x2 w0 = {ub[2][0][0], ub[2][0][1]}, b0 = {ub[2][1][0], ub[2][1][1]}, d0 = {ub[2][2][0], ub[2][2][1]}; const f32x2 r0 = {ub[2][3][0], ub[2][3][1]}; S[22] = S[22] * w0 + sav * b0 + vvv * d0; y2 += S[22] * r0; }
            { const f32x2 w1 = {ub[2][0][2], ub[2][0][3]}, b1 = {ub[2][1][2], ub[2][1][3]}, d1 = {ub[2][2][2], ub[2][2][3]}; const f32x2 r1 = {ub[2][3][2], ub[2][3][3]}; S[23] = S[23] * w1 + sav * b1 + vvv * d1; y2 += S[23] * r1; }
            asm volatile("" : "+v"(S[22]), "+v"(S[23]), "+v"(y2) : "v"(ub[2][0]), "v"(ub[2][1]), "v"(ub[2][2]), "v"(ub[2][3]));
            asm volatile("ds_read_b128 %0, %1 offset:224" : "=v"(ub[2][0]) : "v"(oaddr) : "memory");
            asm volatile("ds_read_b128 %0, %1 offset:480" : "=v"(ub[2][1]) : "v"(oaddr) : "memory");
            asm volatile("ds_read_b128 %0, %1 offset:736" : "=v"(ub[2][2]) : "v"(oaddr) : "memory");
            asm volatile("ds_read_b128 %0, %1 offset:1248" : "=v"(ub[2][3]) : "v"(oaddr) : "memory");
            asm volatile("s_waitcnt lgkmcnt(8)" : "+v"(ub[0][0]), "+v"(ub[0][1]), "+v"(ub[0][2]), "+v"(ub[0][3]) :: "memory");
            { const f32x2 w0 = {ub[0][0][0], ub[0][0][1]}, b0 = {ub[0][1][0], ub[0][1][1]}, d0 = {ub[0][2][0], ub[0][2][1]}; const f32x2 r0 = {ub[0][3][0], ub[0][3][1]}; S[24] = S[24] * w0 + sav * b0 + vvv * d0; y2 += S[24] * r0; }
            { const f32x2 w1 = {ub[0][0][2], ub[0][0][3]}, b1 = {ub[0][1][2], ub[0][1][3]}, d1 = {ub[0][2][2], ub[0][2][3]}; const f32x2 r1 = {ub[0][3][2], ub[0][3][3]}; S[25] = S[25] * w1 + sav * b1 + vvv * d1; y2 += S[25] * r1; }
            asm volatile("" : "+v"(S[24]), "+v"(S[25]), "+v"(y2) : "v"(ub[0][0]), "v"(ub[0][1]), "v"(ub[0][2]), "v"(ub[0][3]));
            asm volatile("ds_read_b128 %0, %1 offset:240" : "=v"(ub[0][0]) : "v"(oaddr) : "memory");
            asm volatile("ds_read_b128 %0, %1 offset:496" : "=v"(ub[0][1]) : "v"(oaddr) : "memory");
            asm volatile("ds_read_b128 %0, %1 offset:752" : "=v"(ub[0][2]) : "v"(oaddr) : "memory");
            asm volatile("ds_read_b128 %0, %1 offset:1264" : "=v"(ub[0][3]) : "v"(oaddr) : "memory");
            asm volatile("s_waitcnt lgkmcnt(8)" : "+v"(ub[1][0]), "+v"(ub[1][1]), "+v"(ub[1][2]), "+v"(ub[1][3]) :: "memory");
            { const f32x2 w0 = {ub[1][0][0], ub[1][0][1]}, b0 = {ub[1][1][0], ub[1][1][1]}, d0 = {ub[1][2][0], ub[1][2][1]}; const f32x2 r0 = {ub[1][3][0], ub[1][3][1]}; S[26] = S[26] * w0 + sav * b0 + vvv * d0; y2 += S[26] * r0; }
            { const f32x2 w1 = {ub[1][0][2], ub[1][0][3]}, b1 = {ub[1][1][2], ub[1][1][3]}, d1 = {ub[1][2][2], ub[1][2][3]}; const f32x2 r1 = {ub[1][3][2], ub[1][3][3]}; S[27] = S[27] * w1 + sav * b1 + vvv * d1; y2 += S[27] * r1; }
            asm volatile("" : "+v"(S[26]), "+v"(S[27]), "+v"(y2) : "v"(ub[1][0]), "v"(ub[1][1]), "v"(ub[1][2]), "v"(ub[1][3]));
            asm volatile("ds_read_b128 %0, %1 offset:768" : "=v"(nk[0]) : "v"(naddr) : "memory");
            asm volatile("ds_read_b128 %0, %1 offset:784" : "=v"(nk[1]) : "v"(naddr) : "memory");
            asm volatile("ds_read_b128 %0, %1 offset:800" : "=v"(nk[2]) : "v"(naddr) : "memory");
            asm volatile("s_waitcnt lgkmcnt(7)" : "+v"(ub[2][0]), "+v"(ub[2][1]), "+v"(ub[2][2]), "+v"(ub[2][3]) :: "memory");
            { const f32x2 w0 = {ub[2][0][0], ub[2][0][1]}, b0 = {ub[2][1][0], ub[2][1][1]}, d0 = {ub[2][2][0], ub[2][2][1]}; const f32x2 r0 = {ub[2][3][0], ub[2][3][1]}; S[28] = S[28] * w0 + sav * b0 + vvv * d0; y2 += S[28] * r0; }
            { const f32x2 w1 = {ub[2][0][2], ub[2][0][3]}, b1 = {ub[2][1][2], ub[2][1][3]}, d1 = {ub[2][2][2], ub[2][2][3]}; const f32x2 r1 = {ub[2][3][2], ub[2][3][3]}; S[29] = S[29] * w1 + sav * b1 + vvv * d1; y2 += S[29] * r1; }
            asm volatile("" : "+v"(S[28]), "+v"(S[29]), "+v"(y2) : "v"(ub[2][0]), "v"(ub[2][1]), "v"(ub[2][2]), "v"(ub[2][3]));
            asm volatile("ds_read_b128 %0, %1 offset:816" : "=v"(nk[3]) : "v"(naddr) : "memory");
            asm volatile("ds_read_b128 %0, %1 offset:832" : "=v"(nk[4]) : "v"(naddr) : "memory");
            asm volatile("ds_read_b128 %0, %1 offset:848" : "=v"(nk[5]) : "v"(naddr) : "memory");
            asm volatile("s_waitcnt lgkmcnt(6)" : "+v"(ub[0][0]), "+v"(ub[0][1]), "+v"(ub[0][2]), "+v"(ub[0][3]) :: "memory");
            { const f32x2 w0 = {ub[0][0][0], ub[0][0][1]}, b0 = {ub[0][1][0], ub[0][1][1]}, d0 = {ub[0][2][0], ub[0][2][1]}; const f32x2 r0 = {ub[0][3][0], ub[0][3][1]}; S[30] = S[30] * w0 + sav * b0 + vvv * d0; y2 += S[30] * r0; }
            { const f32x2 w1 = {ub[0][0][2], ub[0][0][3]}, b1 = {ub[0][1][2], ub[0][1][3]}, d1 = {ub[0][2][2], ub[0][2][3]}; const f32x2 r1 = {ub[0][3][2], ub[0][3][3]}; S[31] = S[31] * w1 + sav * b1 + vvv * d1; y2 += S[31] * r1; }
            asm volatile("" : "+v"(S[30]), "+v"(S[31]), "+v"(y2) : "v"(ub[0][0]), "v"(ub[0][1]), "v"(ub[0][2]), "v"(ub[0][3]));
            asm volatile("ds_read_b128 %0, %1 offset:864" : "=v"(nk[6]) : "v"(naddr) : "memory");
            asm volatile("ds_read_b128 %0, %1 offset:880" : "=v"(nk[7]) : "v"(naddr) : "memory");

            const int jj = R.d == 0 ? sb * RW_T + j : RW_LC - 1 - (sb * RW_T + j); const size_t row = (size_t)R.b * SEQ + R.c * RW_LC + jj;
            wkv[((size_t)R.d * MR + row) * 256 + h * 64 + lane] = y2[0] + y2[1];
            }
        }
        asm volatile("s_waitcnt lgkmcnt(0)" : "+v"(nk[0]), "+v"(nk[1]), "+v"(nk[2]), "+v"(nk[3]), "+v"(nk[4]), "+v"(nk[5]), "+v"(nk[6]), "+v"(nk[7]) :: "memory");
        __syncthreads();
    }
    if (PASS == 1) {
#pragma unroll
        for (int k = 0; k < 16; ++k) { *(f32x4*)(slot + lane * 64 + 4 * k) = (f32x4){P[2 * k][0], P[2 * k][1], P[2 * k + 1][0], P[2 * k + 1][1]};
            *(f32x4*)(slot + 4096 + lane * 64 + 4 * k) = (f32x4){S[2 * k][0], S[2 * k][1], S[2 * k + 1][0], S[2 * k + 1][1]}; }
    }
}
DEV void rw_passB(PP p, float* lds) {
    const int tid = otid(), wave = __builtin_amdgcn_readfirstlane(tid >> 6), lane = tid & 63, i16 = lane & 15, kq = lane >> 4;
    float* Sl = lds; float* Pl = lds + 64 * 68; float* pe = (float*)(p->ws + WS_PE);
    for (int chain = blockIdx.x; chain < 32; chain += gridDim.x) {
        __syncthreads();
#pragma unroll
        for (int e = 0; e < 8; ++e) { const int idx = e * 512 + tid; Sl[(idx >> 6) * 68 + (idx & 63)] = 0.f; }
        float pr[8]; f32x4 er[2];
        { const float* slot = pe + ((size_t)chain * RW_NC) * 8192;
#pragma unroll
          for (int e = 0; e < 8; ++e) pr[e] = slot[e * 512 + tid];
#pragma unroll
          for (int q = 0; q < 2; ++q) { const int id = wave + 8 * q, rt = id >> 2, ct = id & 3;
#pragma unroll
              for (int r = 0; r < 4; ++r) er[q][r] = slot[4096 + (16 * rt + kq * 4 + r) * 64 + 16 * ct + i16]; } }
        for (int sc = 0; sc < RW_NC; ++sc) {
            float* slot = pe + ((size_t)chain * RW_NC + sc) * 8192;
#pragma unroll
            for (int e = 0; e < 8; ++e) { const int idx = e * 512 + tid; Pl[(idx >> 6) * 72 + (idx & 63)] = pr[e]; }
            __syncthreads();
            f32x4 acc[2] = {er[0], er[1]};
            if (sc + 1 < RW_NC) { const float* nslot = slot + 8192;
#pragma unroll
                for (int e = 0; e < 8; ++e) pr[e] = nslot[e * 512 + tid];
#pragma unroll
                for (int q = 0; q < 2; ++q) { const int id = wave + 8 * q, rt = id >> 2, ct = id & 3;
#pragma unroll
                    for (int r = 0; r < 4; ++r) er[q][r] = nslot[4096 + (16 * rt + kq * 4 + r) * 64 + 16 * ct + i16]; } }
#pragma unroll
            for (int q = 0; q < 2; ++q) { const int id = wave + 8 * q, rt = id >> 2, ct = id & 3;
                acc[q] = mm16(Sl + 16 * rt * 68, 68, 1, Pl + 16 * ct, 72, 1, 0, 64, acc[q], lane);
#pragma unroll
                for (int r = 0; r < 4; ++r) { const int row = 16 * rt + kq * 4 + r, col = 16 * ct + i16; slot[4096 + row * 64 + col] = Sl[row * 68 + col]; } }
            __syncthreads();
#pragma unroll
            for (int q = 0; q < 2; ++q) { const int id = wave + 8 * q, rt = id >> 2, ct = id & 3;
#pragma unroll
                for (int r = 0; r < 4; ++r) Sl[(16 * rt + kq * 4 + r) * 68 + 16 * ct + i16] = acc[q][r]; }
        }
    }
}
DEV void rw_final(PP p, int l, float* lds) {
    const int tid = otid(), tg = tid >> 8, c = tid & 255, h = c >> 6;
    const bf16_t* z = (const bf16_t*)(p->ws + WS_BIG); bf16_t* Y = (bf16_t*)(p->ws + WS_XB);
    const float* mu = p->in[10] + l * 960; const float* g2 = p->in[15] + l * 16384; const float* wkv = (const float*)(p->ws + WS_WKV); const float* sbon = (const float*)(p->ws + WS_SBON);
    const float lnw = p->in[19][l * 256 + c], lnb = p->in[20][l * 256 + c];
    float g2r[64];
#pragma unroll
    for (int r = 0; r < 64; ++r) g2r[r] = g2[r * 256 + c];
    float* sgl = lds;
    for (int tile = blockIdx.x; tile < MR / 32; tile += gridDim.x) {
        const int row0 = tile * 32;
#pragma unroll
        for (int e = 0; e < 4; ++e) { const int idx = e * 512 + tid, tok = idx >> 6, r = idx & 63; const int row = row0 + tok;
            sgl[tok * 64 + r] = sigmoid_f(rw_shift(z, row, row & (SEQ - 1), 896 + r, mu)); }
        __syncthreads();
        for (int q = 0; q < 16; ++q) { const int tok = tg * 16 + q; const size_t row = row0 + tok; const int t = (int)(row & (SEQ - 1));
            float gate = 0.f;
#pragma unroll
            for (int r = 0; r < 64; ++r) gate += sgl[tok * 64 + r] * g2r[r];
            const float wk = wkv[row * 256 + c] + wkv[((size_t)MR + row) * 256 + c];
            const float mean = wave_sum(wk) * (1.f / 64.f); const float dv = wk - mean; const float var = wave_sum(dv * dv) * (1.f / 64.f);
            const float nrm = dv * rsqrtf(var + 64e-5f);
            const float vsh = rw_shift(z, row, t, 512 + c, mu);
            const float bon = (sbon[row * 4 + h] + sbon[((size_t)MR + row) * 4 + h]) * vsh;
            const float out = (nrm * lnw + lnb + bon) * gate;
            Y[row * DM + 512 + c] = (bf16_t)f2bf(out); }
        __syncthreads();
    }
}

#define XB_TMO      128
#define XB_XCNT(j)  (256  + 64 * (j))
#define XB_XSUB(j)  (1280 + 64 * (j))
#define XB_XGEN(j)  (2304 + 64 * (j))
#define XB_TOP      3328
#define XB_TOPGEN   3392
#define XCD_BAR_WORDS 3456
#define XB_SPIN_CAP (1u << 18)

__device__ __forceinline__ unsigned xb_ld(unsigned* p)              { return __hip_atomic_load(p, __ATOMIC_RELAXED, __HIP_MEMORY_SCOPE_AGENT); }
__device__ __forceinline__ unsigned xb_add(unsigned* p, unsigned v) { return __hip_atomic_fetch_add(p, v, __ATOMIC_RELAXED, __HIP_MEMORY_SCOPE_AGENT); }
__device__ __forceinline__ unsigned xb_xcc_id() { return (unsigned)__builtin_amdgcn_s_getreg((3 << 11) | 20) & 0xFu; }
#define XB_SPIN(cond, bar) do { unsigned _sp = 0; while (cond) { __builtin_amdgcn_s_sleep(1); \
    if ((++_sp & 255u) == 0u) { if (xb_ld(&(bar)[XB_TMO])) break; if (_sp > XB_SPIN_CAP) { atomicAdd(&(bar)[XB_TMO], 1u); break; } } } } while (0)

struct XcdBarrier {
    unsigned* bar; unsigned x;
    volatile __attribute__((address_space(3))) unsigned* st;
};

__device__ __forceinline__ XcdBarrier xcd_barrier_post(unsigned* bar, volatile __attribute__((address_space(3))) unsigned* st) {
    XcdBarrier b; b.bar = bar; b.x = xb_xcc_id(); b.st = st;
    if (threadIdx.x == 0) (void)xb_add(&bar[XB_XCNT(b.x)], 1u);
    return b;
}
__device__ __forceinline__ void xcd_barrier_complete(unsigned* bar, unsigned x, unsigned& nloc, unsigned& nx) {
    const unsigned G = gridDim.x * gridDim.y * gridDim.z;
    unsigned sum, cnt, mine, sp = 0u;
    for (;;) {
        sum = 0u; cnt = 0u; mine = 0u;
#pragma unroll
        for (unsigned j = 0; j < 16; ++j) { const unsigned c = xb_ld(&bar[XB_XCNT(j)]); sum += c; cnt += (c > 0u) ? 1u : 0u; mine = (j == x) ? c : mine; }
        if (sum == G) break;
        __builtin_amdgcn_s_sleep(1);
        if ((++sp & 255u) == 0u) { if (xb_ld(&bar[XB_TMO])) break; if (sp > XB_SPIN_CAP) { atomicAdd(&bar[XB_TMO], 1u); break; } }
    }
    nloc = mine > 0u ? mine : 1u; nx = cnt > 0u ? cnt : 1u;
}

__device__ __forceinline__ void xcd_barrier(const XcdBarrier& b) {
    asm volatile("s_waitcnt vmcnt(0)" ::: "memory");
    __syncthreads();
    if (threadIdx.x == 0) {
        unsigned* bar = b.bar;
        __builtin_amdgcn_s_waitcnt(0);
        unsigned nloc = b.st[0], nx = b.st[1];
        if (nloc == 0u) { xcd_barrier_complete(bar, b.x, nloc, nx); b.st[0] = nloc; b.st[1] = nx; }
        const unsigned old = xb_add(&bar[XB_XSUB(b.x)], 1u);
        const unsigned gen = old / nloc;
        if (old + 1u == (gen + 1u) * nloc) {
            __builtin_amdgcn_fence(__ATOMIC_RELEASE, "agent");
            asm volatile("s_waitcnt vmcnt(0)" ::: "memory");
            const unsigned og = xb_add(&bar[XB_TOP], 1u);
            const unsigned tg = og / nx;
            if (og + 1u == (tg + 1u) * nx) xb_add(&bar[XB_TOPGEN], 1u);
            else XB_SPIN(xb_ld(&bar[XB_TOPGEN]) == tg, bar);
            __builtin_amdgcn_fence(__ATOMIC_ACQUIRE, "agent");
            xb_add(&bar[XB_XGEN(b.x)], 1u);
            asm volatile("s_waitcnt vmcnt(0)" ::: "memory");
        } else {
            XB_SPIN(xb_ld(&bar[XB_XGEN(b.x)]) == gen, bar);
            __builtin_amdgcn_fence(__ATOMIC_ACQUIRE, "agent");
            asm volatile("s_waitcnt vmcnt(0)" ::: "memory");
        }
    }
    __syncthreads();
}

#ifndef REP_RW
#define REP_RW 1
#endif
#ifndef REP_SYNC
#define REP_SYNC 1
#endif
#ifndef REP_ROW
#define REP_ROW 0
#endif
#ifndef REP_FIN
#define REP_FIN 1
#endif
#ifndef REP_MIX
#define REP_MIX 1
#endif
DEV void mix_items(PP p, int l, int pass, float* ldsf) {
    unsigned char* ws = p->ws; const bf16_t* BIG = (const bf16_t*)(ws + WS_BIG); bf16_t* XB = (bf16_t*)(ws + WS_XB);
    for (int it = blockIdx.x; it < 2 * NB * NH * NCH; it += gridDim.x) { MixCtx m; const int mode = it >= NB * NH * NCH; const int r = it - mode * NB * NH * NCH;
        m.mode = mode; m.z = BIG; m.rope = (const float*)(ws + WS_ROPE); m.b = r / (NH * NCH); m.h = (r / NCH) % NH; m.c = r % NCH;
        { const float x0 = p->in[9][l * 8 + m.h], x1 = p->in[9][l * 8 + 4 + m.h];
          m.lg0 = fminf(x0, 0.f) - log1pf(__expf(-fabsf(x0))); m.lg1 = fminf(x1, 0.f) - log1pf(__expf(-fabsf(x1)));
          m.ib0 = p->in[21][l * 8 + m.h]; m.ib1 = p->in[21][l * 8 + 4 + m.h]; m.fb0 = p->in[22][l * 8 + m.h]; m.fb1 = p->in[22][l * 8 + 4 + m.h]; }
        if (pass == 0) mix_passA(m, ldsf, (float*)(ws + (mode ? WS_MLC : WS_RET)), (float*)(ws + WS_MLN), (float*)(ws + WS_MLS));
        else mix_passC(m, ldsf, (const float*)(ws + (mode ? WS_MLC : WS_RET)), (const float*)(ws + WS_MLN), (const float*)(ws + WS_MLS), XB, p->in[23] + l * 256); }
}
__global__ void __launch_bounds__(512, 2) mega_fwd(Params pdummy) {
    extern __shared__ __attribute__((aligned(16))) unsigned char lds_raw[];
    cg::grid_group grid = cg::this_grid();
    float* ldsf = (float*)lds_raw; PG8_LAS unsigned char* ldsg = (PG8_LAS unsigned char*)lds_raw;
    volatile __attribute__((address_space(3))) unsigned* bst = (volatile __attribute__((address_space(3))) unsigned*)(ldsg + (LDS_BYTES - 64));
    unsigned* barw;
    { PP p = fresh_params(); barw = (unsigned*)(p->ws + 4096);
      if (threadIdx.x < 2) bst[threadIdx.x] = 0u;
      if (blockIdx.x == 0) { for (int i = threadIdx.x; i < XCD_BAR_WORDS; i += 512) __hip_atomic_store(barw + i, 0u, __ATOMIC_RELAXED, __HIP_MEMORY_SCOPE_AGENT); }
      __syncthreads(); }
    { PP p = fresh_params(); unsigned char* ws = p->ws;
      convert_weights(p, 0, ldsf);
      float* rope = (float*)(ws + WS_ROPE); const int tid = otid();
      for (int i = blockIdx.x * 512 + tid; i < SEQ * 32; i += gridDim.x * 512) { const int t = i >> 5, k = i & 31;
          const float inv = powf(10000.f, -(float)(2 * k) / 64.f); const float ang = (float)t * inv;
          const double ad = (double)ang; const double rev = ad * 0.15915494309189535; const double fr = rev - rint(rev); const float rr = (float)(fr * 6.283185307179586);
          (void)rr; rope[i] = __builtin_amdgcn_cosf((float)fr); rope[SEQ * 32 + i] = __builtin_amdgcn_sinf((float)fr); }
      row_phase(p->in[0], p->out, nullptr, nullptr, 0.f, p->in[1], (bf16_t*)(ws + WS_XB)); }
    __threadfence();
    grid.sync();
    XcdBarrier xbar = xcd_barrier_post(barw, bst);
    for (int ph = 0; ph < 26; ++ph) {
        const int phu = __builtin_amdgcn_readfirstlane(ph);
        const int l = phu >= 13 ? 1 : 0, k = phu - 13 * l;
        PP p = fresh_params(); unsigned char* ws = p->ws; const int G = gridDim.x;
        bf16_t* XB = (bf16_t*)(ws + WS_XB); bf16_t* BIG = (bf16_t*)(ws + WS_BIG); bf16_t* DB = (bf16_t*)(ws + WS_D);
        const float* g = p->in[1] + (size_t)l * 6 * DM;
        if (k == 0 || k == 10) {
            const int f = k == 10;
            pg8::Gemm gm{XB, (const bf16_t*)(ws + WS_WGU + (size_t)f * 11 * MiB), MR, 2 * DFF, DM}; pg8::StaticOrder S; S.init(MR, 2 * DFF, G, (int)blockIdx.x); pg8::EpiSwiGLU E{BIG, DFF};
            pg8::gemm_phase<pg8::EpiSwiGLU, pg8::StaticOrder, true, true>(ldsg, gm, S, E);
        } else if (k == 1 || k == 11 || k == 3 || k == 8) {
            const bf16_t* A; const bf16_t* Bt; bf16_t* O; int N, K;
            if (k == 3) { A = XB; Bt = (const bf16_t*)(ws + WS_WIN); O = BIG; N = ZLD; K = DM; }
            else if (k == 8) { A = XB; Bt = (const bf16_t*)(ws + WS_WOUT); O = DB; N = DM; K = DM; }
            else { A = BIG; Bt = (const bf16_t*)(ws + WS_WD + (size_t)(k == 11) * (11 * MiB / 2)); O = DB; N = DM; K = DFF; }
            pg8::Gemm gm{A, Bt, MR, N, K}; pg8::StaticOrder S; S.init(MR, N, G, (int)blockIdx.x); pg8::EpiBf16 E{O, N};
            pg8::gemm_phase<pg8::EpiBf16, pg8::StaticOrder, true, true>(ldsg, gm, S, E);
        } else if (k == 2) { if (REP_ROW) row_phase(p->out, (float*)(ws + WS_BIG), DB, g + 1 * DM, 0.5f, g + 2 * DM, (bf16_t*)(ws + WS_BIG + 128 * MiB)); row_phase(p->out, p->out, DB, g + 1 * DM, 0.5f, g + 2 * DM, XB);
        } else if (k == 9) { if (REP_ROW) row_phase(p->out, (float*)(ws + WS_BIG), DB, g + 1 * DM, 0.5f, g + 2 * DM, (bf16_t*)(ws + WS_BIG + 128 * MiB)); row_phase(p->out, p->out, DB, g + 3 * DM, 1.0f, g + 4 * DM, XB);
        } else if (k == 12) { if (REP_ROW) row_phase(p->out, (float*)(ws + WS_BIG), DB, g + 1 * DM, 0.5f, g + 2 * DM, (bf16_t*)(ws + WS_BIG + 128 * MiB)); row_phase(p->out, p->out, DB, g + 5 * DM, 0.5f, l == 0 ? g + 6 * DM : nullptr, l == 0 ? XB : nullptr);
            if (l == 0) { for (int rf = 0; rf < REP_FIN; ++rf) convert_weights(p, 1, ldsf); }
        } else if (k == 4) {
            for (int rep = 0; rep < REP_RW; ++rep) { for (int task = blockIdx.x; task < NB * RW_NC * 2; task += G) rw_task<1>(p, l, task, ldsf);
            __syncthreads(); }
            for (int rep = 0; rep < REP_MIX; ++rep) mix_items(p, l, 0, ldsf);
            for (int rf = 0; rf < REP_FIN; ++rf) conv_mixer(p, l, BIG, XB);
        } else if (k == 5) { rw_passB(p, ldsf); mix_passB(p, l, ldsf + 64 * 68 + 64 * 72);
        } else if (k == 6) {
            for (int rep = 0; rep < REP_RW; ++rep) { for (int task = blockIdx.x; task < NB * RW_NC * 2; task += G) rw_task<2>(p, l, task, ldsf);
            __syncthreads(); }
            for (int rep = 0; rep < REP_MIX; ++rep) mix_items(p, l, 1, ldsf);
        } else { for (int rf = 0; rf < REP_FIN; ++rf) rw_final(p, l, ldsf); }
        if (ph != 25) { for (int rs = 0; rs < REP_SYNC; ++rs) xcd_barrier(xbar); }
    }
}

extern "C" void kernel_launch(void* const* d_in, const int* in_sizes, int n_in, void* d_out, int out_size, void* d_ws, size_t ws_size, hipStream_t stream) {
    static int grid = 0;
    if (grid == 0) {
        int dev = 0, cus = 0, per_cu = 0;
        (void)hipGetDevice(&dev); (void)hipDeviceGetAttribute(&cus, hipDeviceAttributeMultiprocessorCount, dev);
        (void)hipFuncSetAttribute((const void*)mega_fwd, hipFuncAttributeMaxDynamicSharedMemorySize, LDS_BYTES);
        (void)hipOccupancyMaxActiveBlocksPerMultiprocessor(&per_cu, (const void*)mega_fwd, 512, LDS_BYTES);
        if (per_cu < 1) fprintf(stderr, "occupancy query says %d blocks/CU\n", per_cu);
        (void)hipGetLastError();
        grid = cus;
        if (ws_size < WS_END) fprintf(stderr, "kernel_launch: workspace too small: %zu < %zu\n", ws_size, (size_t)WS_END);
    }
    Params p{};
    for (int i = 0; i < 24; ++i) p.in[i] = (const float*)d_in[i];
    p.out = (float*)d_out; p.ws = (unsigned char*)d_ws;
    void* args[] = {&p};
    hipError_t e = hipLaunchCooperativeKernel((const void*)mega_fwd, dim3(grid), dim3(512), args, LDS_BYTES, stream);
    if (e != hipSuccess) fprintf(stderr, "cooperative launch failed: %s (grid %d)\n", hipGetErrorString(e), grid);
}
```
